# Optimizing an MI355X kernel written in HIP

```python
import jax, jax.numpy as jnp
from jax import lax
import numpy as np

D_MODEL = 1024
BATCH = 2
SEQ = 16384
DEPTH = 2

GRID_W = 64
CTX_LEN = 256
CHUNK = 64
CONV_W = 5
POOL_WINDOWS = (2, 4, 8, 16)
POOL_DIM = D_MODEL // 4
POOL_GROUP = POOL_DIM // len(POOL_WINDOWS)
SSD_DIM = 3 * D_MODEL // 8
SSD_HEAD_DIM = 64
SSD_HEADS = SSD_DIM // SSD_HEAD_DIM
SSD_GROUPS = 2
SSD_STATE = 128
SSD_BC = SSD_GROUPS * SSD_STATE
GDN_DIM = 3 * D_MODEL // 8
GDN_HEAD_DIM = 64
GDN_HEADS = GDN_DIM // GDN_HEAD_DIM
D_MIX = POOL_DIM + SSD_DIM + GDN_DIM
IN_SPLITS = (POOL_DIM, SSD_DIM, SSD_DIM + 2 * SSD_BC, 2 * SSD_HEADS, 3 * GDN_DIM, GDN_DIM, 2 * GDN_HEADS, 2 * GDN_HEADS)
IN_DIM = sum(IN_SPLITS)
N_EXPERTS = 16
EC_CAPACITY = 2
EXPERT_FF = D_MODEL // 2
EPS = 1e-6
F32 = jnp.float32

kernel_name = "hybrid_pool_ssd_gdn_ec_moe_dit"


def rms_norm(x, g):
    x32 = x.astype(F32)
    y = x32 * lax.rsqrt(jnp.mean(x32 * x32, axis=-1, keepdims=True) + EPS) * g.astype(F32)
    return y.astype(x.dtype)


def l2_norm(a):
    return a * lax.rsqrt(jnp.sum(a * a, axis=-1, keepdims=True) + EPS)


def modulate(h, shift, scale):
    return h * (1 + scale[:, None]) + shift[:, None]


def flip_t(a):
    return jnp.flip(a, axis=1)


def to_column_major(u):
    b, T, C = u.shape
    rows = T // GRID_W
    return u.reshape(b, rows, GRID_W, C).transpose(0, 2, 1, 3).reshape(b, T, C)


def to_raster(u):
    b, T, C = u.shape
    rows = T // GRID_W
    return u.reshape(b, GRID_W, rows, C).transpose(0, 2, 1, 3).reshape(b, T, C)


def to_chunks(a):
    b, T = a.shape[:2]
    a = a.reshape((b, T // CHUNK, CHUNK) + a.shape[2:])
    return jnp.moveaxis(a, 2, 3)


def dwconv_centred(u, w):
    k, ch = w.shape
    return lax.conv_general_dilated(u, w[:, None, :], window_strides=(1,), padding=[(k // 2, k // 2)],
                                    dimension_numbers=('NWC', 'WIO', 'NWC'), feature_group_count=ch)


def pool_branch(u, pool_w, pool_scale):
    b, T, _ = u.shape
    u32 = u.astype(F32)
    csum = jnp.concatenate([jnp.zeros((b, 1, POOL_DIM), F32), jnp.cumsum(u32, axis=1)], axis=1)
    t = jnp.arange(T)
    groups = []
    for gi, win in enumerate(POOL_WINDOWS):
        lo = jnp.clip(t - win // 2, 0, T)
        hi = jnp.clip(t + win // 2, 0, T)
        sl = slice(gi * POOL_GROUP, (gi + 1) * POOL_GROUP)
        cg = csum[:, :, sl]
        mean = (cg[:, hi] - cg[:, lo]) / (hi - lo).astype(F32)[None, :, None]
        groups.append(mean - u32[:, :, sl])
    d = jnp.stack(groups, axis=2)
    y = jnp.einsum('btgc,gcd->btgd', d, pool_w.astype(F32)).reshape(b, T, POOL_DIM) * pool_scale.astype(F32)
    return y.astype(u.dtype)


def ssd_chunked(xdt, log_a, bm, cm, s0):
    b, T, H, P = xdt.shape
    xc, bc, cc = to_chunks(xdt), to_chunks(bm), to_chunks(cm)
    ac = jnp.cumsum(to_chunks(log_a), axis=-1)
    lower = jnp.tril(jnp.ones((CHUNK, CHUNK), bool))
    decay = jnp.exp(jnp.where(lower, ac[..., :, None] - ac[..., None, :], -jnp.inf))
    y_intra = jnp.einsum('bchij,bchjp->bchip', jnp.einsum('bchis,bchjs->bchij', cc, bc) * decay, xc)
    states = jnp.einsum('bchjs,bchjp->bchsp', bc * jnp.exp(ac[..., -1:] - ac)[..., None], xc)
    chunk_decay = jnp.exp(ac[..., -1])

    def step(s, inp):
        st, dc = inp
        return s * dc[..., None, None] + st, s

    s_fin, s_start = lax.scan(step, s0, (jnp.moveaxis(states, 1, 0), jnp.moveaxis(chunk_decay, 1, 0)))
    s_start = jnp.moveaxis(s_start, 0, 1)
    y_inter = jnp.einsum('bchis,bchsp->bchip', cc * jnp.exp(ac)[..., None], s_start)
    y = jnp.moveaxis(y_intra + y_inter, 2, 3).reshape(b, T, H, P)
    return y, s_fin


def gdn_chunked(q, k, v, g, beta, s0):
    b, T, H, _ = q.shape
    V = v.shape[-1]
    qc, kc, vc = to_chunks(q), to_chunks(k), to_chunks(v)
    gc = jnp.cumsum(to_chunks(g), axis=-1)
    bc = to_chunks(beta)
    lower = jnp.tril(jnp.ones((CHUNK, CHUNK), bool))
    strict = jnp.tril(jnp.ones((CHUNK, CHUNK), bool), -1)
    decay = jnp.exp(jnp.where(lower, gc[..., :, None] - gc[..., None, :], -jnp.inf))
    kb = kc * bc[..., None]
    xm = jnp.where(strict, jnp.einsum('bnhik,bnhjk->bnhij', kb, kc) * decay, 0.0)
    eye = jnp.eye(CHUNK, dtype=xm.dtype)
    tm = lax.linalg.triangular_solve(xm + eye, jnp.broadcast_to(eye, xm.shape), left_side=True, lower=True,
                                     unit_diagonal=True)
    u = jnp.einsum('bnhij,bnhjv->bnhiv', tm, vc * bc[..., None])
    w = jnp.einsum('bnhij,bnhjk->bnhik', tm, kb * jnp.exp(gc)[..., None])
    attn = jnp.einsum('bnhik,bnhjk->bnhij', qc, kc) * decay
    qg = qc * jnp.exp(gc)[..., None]
    kend = kc * jnp.exp(gc[..., -1:] - gc)[..., None]
    gend = jnp.exp(gc[..., -1])

    def step(s, inp):
        u_i, w_i, a_i, qg_i, ke_i, ge_i = inp
        v_new = u_i - jnp.einsum('bhlk,bhkv->bhlv', w_i, s)
        o_i = jnp.einsum('bhlk,bhkv->bhlv', qg_i, s) + jnp.einsum('bhij,bhjv->bhiv', a_i, v_new)
        s = s * ge_i[..., None, None] + jnp.einsum('bhlk,bhlv->bhkv', ke_i, v_new)
        return s, o_i

    xs = (jnp.moveaxis(u, 1, 0), jnp.moveaxis(w, 1, 0), jnp.moveaxis(attn, 1, 0),
          jnp.moveaxis(qg, 1, 0), jnp.moveaxis(kend, 1, 0), jnp.moveaxis(gend, 1, 0))
    s_fin, o = lax.scan(step, s0, xs)
    o = jnp.moveaxis(jnp.moveaxis(o, 0, 1), 2, 3).reshape(b, T, H, V)
    return o, s_fin


def ssd_stream(z, xbc, dt_raw, conv_w, conv_b, a_log, dt_bias, d_skip, norm_g, s0_f, s0_b):
    b, T, _ = z.shape
    xbc = jax.nn.silu(dwconv_centred(xbc, conv_w) + conv_b).astype(F32)
    xs, bm, cm = jnp.split(xbc, [SSD_DIM, SSD_DIM + SSD_BC], axis=-1)
    xs = xs.reshape(b, T, SSD_HEADS, SSD_HEAD_DIM)
    rep = SSD_HEADS // SSD_GROUPS
    bm = jnp.repeat(bm.reshape(b, T, SSD_GROUPS, SSD_STATE), rep, axis=2)
    cm = jnp.repeat(cm.reshape(b, T, SSD_GROUPS, SSD_STATE), rep, axis=2)
    dt = jax.nn.softplus(dt_raw.astype(F32).reshape(b, T, 2, SSD_HEADS) + dt_bias.astype(F32))
    a = -jnp.exp(a_log.astype(F32))
    y_f, s_f = ssd_chunked(xs * dt[:, :, 0, :, None], dt[:, :, 0] * a[0], bm, cm, s0_f)
    y_b, s_b = ssd_chunked(flip_t(xs * dt[:, :, 1, :, None]), flip_t(dt[:, :, 1] * a[1]), flip_t(bm), flip_t(cm), s0_b)
    y = y_f + flip_t(y_b) + d_skip.astype(F32)[:, None] * xs
    y = y.reshape(b, T, SSD_DIM) * jax.nn.silu(z.astype(F32))
    return rms_norm(y, norm_g).astype(z.dtype), s_f, s_b


def gdn_stream(qkv, gate, a_raw, b_raw, conv_w, a_log, dt_bias, norm_g, s0_f, s0_b):
    b, T, _ = qkv.shape
    qkv = jax.nn.silu(dwconv_centred(qkv, conv_w)).astype(F32)
    q, k, v = [t.reshape(b, T, GDN_HEADS, GDN_HEAD_DIM) for t in jnp.split(qkv, 3, axis=-1)]
    q = l2_norm(q) * (GDN_HEAD_DIM ** -0.5)
    k = l2_norm(k)
    g = -jnp.exp(a_log.astype(F32)) * jax.nn.softplus(a_raw.astype(F32).reshape(b, T, 2, GDN_HEADS) + dt_bias.astype(F32))
    beta = jax.nn.sigmoid(b_raw.astype(F32).reshape(b, T, 2, GDN_HEADS))
    o_f, s_f = gdn_chunked(q, k, v, g[:, :, 0], beta[:, :, 0], s0_f)
    o_b, s_b = gdn_chunked(flip_t(q), flip_t(k), flip_t(v), flip_t(g[:, :, 1]), flip_t(beta[:, :, 1]), s0_b)
    o = rms_norm(o_f + flip_t(o_b), norm_g).reshape(b, T, GDN_DIM) * jax.nn.silu(gate.astype(F32))
    return o.astype(gate.dtype), s_f, s_b


def hybrid_mixer(h_ctx, h_lat, w_in, w_out, pool_w, pool_scale, ssd_conv_w, ssd_conv_b, ssd_a_log, ssd_dt_bias,
                 ssd_d, ssd_norm_g, gdn_conv_w, gdn_a_log, gdn_dt_bias, gdn_norm_g, with_ctx_out):
    b = h_lat.shape[0]
    cut = np.cumsum(IN_SPLITS)[:-1].tolist()
    pc = jnp.split(h_ctx @ w_in, cut, axis=-1)
    pl = jnp.split(h_lat @ w_in, cut, axis=-1)
    ssd_p = (ssd_conv_w, ssd_conv_b, ssd_a_log, ssd_dt_bias, ssd_d, ssd_norm_g)
    gdn_p = (gdn_conv_w, gdn_a_log, gdn_dt_bias, gdn_norm_g)
    zs = jnp.zeros((b, SSD_HEADS, SSD_STATE, SSD_HEAD_DIM), F32)
    zg = jnp.zeros((b, GDN_HEADS, GDN_HEAD_DIM, GDN_HEAD_DIM), F32)
    s_ctx, ssd_sf, ssd_sb = ssd_stream(pc[1], pc[2], pc[3], *ssd_p, zs, zs)
    g_ctx, gdn_sf, gdn_sb = gdn_stream(pc[4], pc[5], pc[6], pc[7], *gdn_p, zg, zg)
    s_lat, _, _ = ssd_stream(pl[1], pl[2], pl[3], *ssd_p, ssd_sf, ssd_sb)
    g_lat, _, _ = gdn_stream(to_column_major(pl[4]), to_column_major(pl[5]), to_column_major(pl[6]),
                             to_column_major(pl[7]), *gdn_p, gdn_sf, gdn_sb)
    g_lat = to_raster(g_lat)
    lat = jnp.concatenate([pool_branch(pl[0], pool_w, pool_scale), s_lat, g_lat], axis=-1) @ w_out
    if not with_ctx_out:
        return None, lat
    ctx = jnp.concatenate([pool_branch(pc[0], pool_w, pool_scale), s_ctx, g_ctx], axis=-1) @ w_out
    return ctx, lat


def expert_choice_ffn(h, router_w, w_gate, w_up, w_down):
    b, T, D = h.shape
    cap = EC_CAPACITY * T // N_EXPERTS
    aff = jax.nn.softmax(jnp.einsum('btd,de->bte', h.astype(F32), router_w.astype(F32)), axis=-1)
    gate, idx = lax.top_k(jnp.swapaxes(aff, 1, 2), cap)
    xe = jax.vmap(lambda hb, ib: hb[ib])(h, idx)
    hid = jax.nn.silu(jnp.einsum('becd,edf->becf', xe, w_gate)) * jnp.einsum('becd,edf->becf', xe, w_up)
    ye = jnp.einsum('becf,efd->becd', hid, w_down) * gate[..., None].astype(h.dtype)
    return jax.vmap(lambda ib, yb: jnp.zeros((T, D), yb.dtype).at[ib.reshape(-1)].add(yb.reshape(-1, D)))(idx, ye)


def setup_inputs(seed: int = 0) -> dict:
    key = jax.random.key(seed)
    ks = iter(jax.random.split(key, 40))

    def nrm(shape, s):
        return jax.random.normal(next(ks), shape, F32) * s

    def gain(shape):
        return 1.0 + nrm(shape, 0.05)

    def dt_bias(shape):
        dt = jnp.exp(jax.random.uniform(next(ks), shape, F32, np.log(1e-3), np.log(1e-1)))
        return dt + jnp.log(-jnp.expm1(-dt))

    def a_log(shape):
        return jnp.log(jax.random.uniform(next(ks), shape, F32, 1.0, 16.0))

    L = DEPTH
    return {
        "x": nrm((BATCH, SEQ, D_MODEL), 1.0),
        "c": nrm((BATCH, D_MODEL), 1.0),
        "ctx": nrm((BATCH, CTX_LEN, D_MODEL), 1.0),
        "c_ctx": nrm((D_MODEL,), 1.0),
        "norm1_g": gain((L, D_MODEL)),
        "norm2_g": gain((L, D_MODEL)),
        "ada_w": nrm((L, D_MODEL, 6 * D_MODEL), 0.5 * D_MODEL ** -0.5),
        "ada_b": nrm((L, 6 * D_MODEL), 0.02),
        "w_in": nrm((L, D_MODEL, IN_DIM), D_MODEL ** -0.5),
        "w_out": nrm((L, D_MIX, D_MODEL), D_MIX ** -0.5),
        "pool_w": nrm((L, len(POOL_WINDOWS), POOL_GROUP, POOL_GROUP), POOL_GROUP ** -0.5),
        "pool_scale": gain((L, POOL_DIM)),
        "ssd_conv_w": nrm((L, CONV_W, SSD_DIM + 2 * SSD_BC), CONV_W ** -0.5),
        "ssd_conv_b": nrm((L, SSD_DIM + 2 * SSD_BC), 0.02),
        "ssd_a_log": a_log((L, 2, SSD_HEADS)),
        "ssd_dt_bias": dt_bias((L, 2, SSD_HEADS)),
        "ssd_d": gain((L, SSD_HEADS)),
        "ssd_norm_g": gain((L, SSD_DIM)),
        "gdn_conv_w": nrm((L, CONV_W, 3 * GDN_DIM), CONV_W ** -0.5),
        "gdn_a_log": a_log((L, 2, GDN_HEADS)),
        "gdn_dt_bias": dt_bias((L, 2, GDN_HEADS)),
        "gdn_norm_g": gain((L, GDN_HEAD_DIM)),
        "router_w": nrm((L, D_MODEL, N_EXPERTS), D_MODEL ** -0.5),
        "exp_w_gate": nrm((L, N_EXPERTS, D_MODEL, EXPERT_FF), D_MODEL ** -0.5),
        "exp_w_up": nrm((L, N_EXPERTS, D_MODEL, EXPERT_FF), D_MODEL ** -0.5),
        "exp_w_down": nrm((L, N_EXPERTS, EXPERT_FF, D_MODEL), EXPERT_FF ** -0.5),
        "final_norm_g": gain((D_MODEL,)),
    }


def reference(x, c, ctx, c_ctx, norm1_g, norm2_g, ada_w, ada_b, w_in, w_out, pool_w, pool_scale, ssd_conv_w,
              ssd_conv_b, ssd_a_log, ssd_dt_bias, ssd_d, ssd_norm_g, gdn_conv_w, gdn_a_log, gdn_dt_bias, gdn_norm_g,
              router_w, exp_w_gate, exp_w_up, exp_w_down, final_norm_g):
    sc = jax.nn.silu(c)
    scc = jax.nn.silu(c_ctx)[None]
    for l in range(DEPTH):
        last = l == DEPTH - 1
        m_lat = jnp.split(sc @ ada_w[l] + ada_b[l], 6, axis=-1)
        m_ctx = jnp.split(scc @ ada_w[l] + ada_b[l], 6, axis=-1)
        h_lat = modulate(rms_norm(x, norm1_g[l]), m_lat[0], m_lat[1])
        h_ctx = modulate(rms_norm(ctx, norm1_g[l]), m_ctx[0], m_ctx[1])
        mix_ctx, mix_lat = hybrid_mixer(h_ctx, h_lat, w_in[l], w_out[l], pool_w[l], pool_scale[l], ssd_conv_w[l],
                                        ssd_conv_b[l], ssd_a_log[l], ssd_dt_bias[l], ssd_d[l], ssd_norm_g[l],
                                        gdn_conv_w[l], gdn_a_log[l], gdn_dt_bias[l], gdn_norm_g[l], not last)
        x = x + m_lat[2][:, None] * mix_lat
        h_lat = modulate(rms_norm(x, norm2_g[l]), m_lat[3], m_lat[4])
        x = x + m_lat[5][:, None] * expert_choice_ffn(h_lat, router_w[l], exp_w_gate[l], exp_w_up[l], exp_w_down[l])
        if not last:
            ctx = ctx + m_ctx[2][:, None] * mix_ctx
            h_ctx = modulate(rms_norm(ctx, norm2_g[l]), m_ctx[3], m_ctx[4])
            ctx = ctx + m_ctx[5][:, None] * expert_choice_ffn(h_ctx, router_w[l], exp_w_gate[l], exp_w_up[l],
                                                               exp_w_down[l])
    return rms_norm(x, final_norm_g)
```

```cpp
#include <hip/hip_runtime.h>
#include <hip/hip_cooperative_groups.h>
#include <cstdio>
#include <cstdint>

#define LAS __attribute__((address_space(3)))
typedef unsigned short bf16_t;
typedef short bf16x8 __attribute__((ext_vector_type(8)));
typedef float f32x4 __attribute__((ext_vector_type(4)));
typedef unsigned u32x4 __attribute__((ext_vector_type(4)));
typedef unsigned u32x2 __attribute__((ext_vector_type(2)));
typedef float f32x2 __attribute__((ext_vector_type(2)));

constexpr int D = 1024, NB = 2, T = 16384, TC = 256, NLAT = NB * T, NROWS = NLAT + NB * TC;
constexpr int NL = 2;
constexpr int IN_DIM = 3108, NPAD = 3328;
constexpr int P1_LD = 1960, P2_LD = 1152;
constexpr int C_U = 0, C_Z = 256, C_XS = 640, C_BM = 1024, C_CM = 1280, C_DT = 1536, C_GATE = 1548, C_AR = 1932, C_BR = 1944;
constexpr int NCHUNK = 520;
constexpr int NE = 16, FF = 512, CAP_L = 2048, CAP_C = 32;
constexpr float EPS = 1e-6f;
constexpr int NTHR = 256;
constexpr int WG_THREADS = 512;
constexpr int LDS_HALF = 78 * 1024;
constexpr int LDS_BYTES = 2 * LDS_HALF;
#define LTID ((int)(threadIdx.x & 255))
#define VB ((int)(blockIdx.x * 2 + __builtin_amdgcn_readfirstlane((int)(threadIdx.x >> 8))))
#define NVB ((int)(gridDim.x * 2))
#define PADDED_ITERS(n) (((n) + NVB - 1) / NVB)

constexpr size_t al256(size_t x) { return (x + 255) & ~(size_t)255; }
constexpr size_t WS_CTL = 0;
constexpr size_t WS_CTL2 = 16384;
constexpr size_t WS_MOD = 32768;
constexpr size_t WS_WIN = al256(WS_MOD + (size_t)NL * 3 * 6144 * 4);
constexpr size_t WS_WOUT = WS_WIN + (size_t)NL * NPAD * D * 2;
constexpr size_t WS_CTXX = WS_WOUT + (size_t)NL * D * D * 2;
constexpr size_t WS_AFF = WS_CTXX + (size_t)NB * TC * D * 4;
constexpr size_t WS_SELIDX = WS_AFF + (size_t)NB * NE * (T + TC) * 4;
constexpr size_t WS_SELGATE = WS_SELIDX + (size_t)NB * NE * (CAP_L + CAP_C) * 4;
constexpr size_t WS_SLOT = WS_SELGATE + (size_t)NB * NE * (CAP_L + CAP_C) * 4;
constexpr size_t WS_SSDCD = WS_SLOT + (size_t)NROWS * NE * 4;
constexpr size_t WS_GAUX = al256(WS_SSDCD + (size_t)2 * NCHUNK * 6 * 4);
constexpr int GAUX_N = 272;
constexpr size_t WS_SSQP = al256(WS_GAUX + (size_t)NCHUNK * 6 * GAUX_N * 4);
constexpr size_t WS_RA = al256(WS_SSQP + (size_t)NROWS * 24 * 4);
constexpr size_t RA_BYTES = (size_t)2 * NCHUNK * 6 * 8192 * 2;
constexpr size_t WS_RB = WS_RA + RA_BYTES;
constexpr size_t RB_BYTES = (size_t)NROWS * P1_LD * 2;
constexpr size_t WS_XB = WS_RB + RB_BYTES;
constexpr size_t WS_RC = WS_XB;
constexpr size_t RC_BYTES = (size_t)NROWS * P2_LD * 2;
constexpr size_t WS_RD = WS_RC + RC_BYTES;
constexpr size_t GPREP_BYTES = 57344;
constexpr size_t RD_BYTES = (size_t)NCHUNK * 6 * GPREP_BYTES;
constexpr size_t WS_END = WS_RD + RD_BYTES;
static_assert(WS_END <= (size_t)536870912, "workspace layout exceeds 512 MiB");
static_assert((size_t)NROWS * D * 2 <= RC_BYTES, "XB fits the old region C slot");
static_assert(RC_BYTES <= (size_t)NLAT * D * 4, "region C fits d_out");
constexpr size_t PART_OFF = (RC_BYTES + 255) / 256 * 256;
constexpr int OP_KS = 8;
static_assert(PART_OFF + (size_t)OP_KS * NB * TC * D * 4 <= (size_t)NLAT * D * 4, "out-proj partials fit d_out");
static_assert((size_t)NROWS * D * 2 <= RA_BYTES, "H fits region A");
static_assert((size_t)3 * NROWS * 384 * 2 <= RC_BYTES, "O_f, O_b and the SSD output fit region C");
static_assert((size_t)NE * D * D * 2 + (size_t)NE * D * FF * 2 <= RC_BYTES, "Wexp fits region C");
static_assert((size_t)NB * NE * (CAP_L + CAP_C) * FF * 2 <= RB_BYTES, "HID fits region B");
static_assert((size_t)NB * NE * (CAP_L + CAP_C) * D * 2 <= RD_BYTES, "YE fits region D");

struct Params {
    const float *x, *c, *ctx, *c_ctx, *norm1_g, *norm2_g, *ada_w, *ada_b, *w_in, *w_out, *pool_w, *pool_scale,
        *ssd_conv_w, *ssd_conv_b, *ssd_a_log, *ssd_dt_bias, *ssd_d, *ssd_norm_g, *gdn_conv_w, *gdn_a_log, *gdn_dt_bias, *gdn_norm_g,
        *router_w, *exp_w_gate, *exp_w_up, *exp_w_down, *final_norm_g;
    float* out; unsigned char* ws; int ph_lo, ph_hi;
};

typedef __bf16 bf16x2_t __attribute__((ext_vector_type(2)));
__device__ __forceinline__ bf16_t f2bf(float f) { const __bf16 h = (__bf16)f; return __builtin_bit_cast(bf16_t, h); }
__device__ __forceinline__ float bf2f(bf16_t h) { return __uint_as_float(((unsigned)h) << 16); }
__device__ __forceinline__ unsigned pk2(float lo, float hi) { const bf16x2_t v = __builtin_convertvector((f32x2){lo, hi}, bf16x2_t); return __builtin_bit_cast(unsigned, v); }
__device__ __forceinline__ float silu_f(float x) { return x * __builtin_amdgcn_rcpf(1.f + __expf(-x)); }
__device__ __forceinline__ float softplus_f(float x) { return fmaxf(x, 0.f) + log1pf(__expf(-fabsf(x))); }
__device__ __forceinline__ float sigmoid_f(float x) { return __builtin_amdgcn_rcpf(1.f + __expf(-x)); }
__device__ __forceinline__ float wave_sum(float v) {
#pragma unroll
    for (int o = 32; o > 0; o >>= 1) v += __shfl_xor(v, o);
    return v;
}
#define MFMA16(a, b, c) __builtin_amdgcn_mfma_f32_16x16x32_bf16((a), (b), (c), 0, 0, 0)
__device__ __forceinline__ bf16x8 ldfrag(const LAS bf16_t* base, int ld, int r0, int k0, int lane) {
    return *(const LAS bf16x8*)(base + (r0 + (lane & 15)) * ld + k0 + 8 * (lane >> 4));
}
__device__ __forceinline__ void unpack8(const u32x4 v, float* f) {
    f[0] = __uint_as_float(v.x << 16); f[1] = __uint_as_float(v.x & 0xffff0000u);
    f[2] = __uint_as_float(v.y << 16); f[3] = __uint_as_float(v.y & 0xffff0000u);
    f[4] = __uint_as_float(v.z << 16); f[5] = __uint_as_float(v.z & 0xffff0000u);
    f[6] = __uint_as_float(v.w << 16); f[7] = __uint_as_float(v.w & 0xffff0000u);
}

__device__ __forceinline__ LAS unsigned char* opaque_lds(LAS unsigned char* p) { asm volatile("" : "+v"(p)); return p; }
__device__ __forceinline__ int opaque_tid() { int t = LTID; asm volatile("" : "+v"(t)); return t; }

#define XB_TMO      128
#define XB_XCNT(j)  (256  + 64 * (j))
#define XB_XSUB(j)  (1280 + 64 * (j))
#define XB_XGEN(j)  (2304 + 64 * (j))
#define XB_TOP      3328
#define XB_TOPGEN   3392
#define XCD_BAR_WORDS 3456
#define XB_SPIN_CAP (1u << 22)
__device__ __forceinline__ unsigned xb_ld(unsigned* p)              { return __hip_atomic_load(p, __ATOMIC_RELAXED, __HIP_MEMORY_SCOPE_AGENT); }
__device__ __forceinline__ unsigned xb_add(unsigned* p, unsigned v) { return __hip_atomic_fetch_add(p, v, __ATOMIC_RELAXED, __HIP_MEMORY_SCOPE_AGENT); }
__device__ __forceinline__ unsigned xb_xcc_id() { return (unsigned)__builtin_amdgcn_s_getreg((3 << 11) | 20) & 0xFu; }
#define XB_SPIN(cond, bar) do { unsigned _sp = 0; while (cond) { __builtin_amdgcn_s_sleep(1); \
    if ((++_sp & 255u) == 0u) { if (xb_ld(&(bar)[XB_TMO])) break; if (_sp > XB_SPIN_CAP) { atomicAdd(&(bar)[XB_TMO], 1u); break; } } } } while (0)
struct XcdBarrier { unsigned* bar; unsigned x; volatile LAS unsigned* st; unsigned G; };
__device__ __forceinline__ XcdBarrier xcd_barrier_post(unsigned* bar, volatile LAS unsigned* st, unsigned G) {
    XcdBarrier b; b.bar = bar; b.x = xb_xcc_id(); b.st = st; b.G = G;
    if (threadIdx.x == 0) (void)xb_add(&bar[XB_XCNT(b.x)], 1u);
    return b;
}
__device__ __forceinline__ void xcd_barrier_complete(unsigned* bar, unsigned x, unsigned G, unsigned& nloc, unsigned& nx) {
    unsigned sum, cnt, mine, sp = 0u;
    for (;;) {
        sum = 0u; cnt = 0u; mine = 0u;
#pragma unroll
        for (unsigned j = 0; j < 16; ++j) { const unsigned c = xb_ld(&bar[XB_XCNT(j)]); sum += c; cnt += (c > 0u) ? 1u : 0u; mine = (j == x) ? c : mine; }
        if (sum == G) break;
        __builtin_amdgcn_s_sleep(1);
        if ((++sp & 255u) == 0u) { if (xb_ld(&bar[XB_TMO])) break; if (sp > XB_SPIN_CAP) { atomicAdd(&bar[XB_TMO], 1u); break; } }
    }
    nloc = mine > 0u ? mine : 1u; nx = cnt > 0u ? cnt : 1u;
}
__device__ __forceinline__ void xcd_barrier(const XcdBarrier& b) {
    asm volatile("s_waitcnt vmcnt(0)" ::: "memory");
    __syncthreads();
    if (threadIdx.x == 0) {
        unsigned* bar = b.bar;
        __builtin_amdgcn_s_waitcnt(0);
        unsigned nloc = b.st[0], nx = b.st[1];
        if (nloc == 0u) { xcd_barrier_complete(bar, b.x, b.G, nloc, nx); b.st[0] = nloc; b.st[1] = nx; }
        const unsigned old = xb_add(&bar[XB_XSUB(b.x)], 1u);
        const unsigned gen = old / nloc;
        if (old + 1u == (gen + 1u) * nloc) {
            __builtin_amdgcn_fence(__ATOMIC_RELEASE, "agent");
            asm volatile("s_waitcnt vmcnt(0)" ::: "memory");
            const unsigned og = xb_add(&bar[XB_TOP], 1u);
            const unsigned tg = og / nx;
            if (og + 1u == (tg + 1u) * nx) xb_add(&bar[XB_TOPGEN], 1u);
            else XB_SPIN(xb_ld(&bar[XB_TOPGEN]) == tg, bar);
            __builtin_amdgcn_fence(__ATOMIC_ACQUIRE, "agent");
            xb_add(&bar[XB_XGEN(b.x)], 1u);
            asm volatile("s_waitcnt vmcnt(0)" ::: "memory");
        } else {
            XB_SPIN(xb_ld(&bar[XB_XGEN(b.x)]) == gen, bar);
            __builtin_amdgcn_fence(__ATOMIC_ACQUIRE, "agent");
            asm volatile("s_waitcnt vmcnt(0)" ::: "memory");
        }
    }
    __syncthreads();
}

__device__ __forceinline__ size_t kb_off(size_t row, int col, size_t nrows) { return ((size_t)(col >> 5) * nrows + row) * 32 + (col & 31); }

__device__ __forceinline__ int row_mset(int row) { return row < T ? 0 : (row < NLAT ? 1 : 2); }
__device__ __forceinline__ int gdn_pos_row(int set, int p) {
    if (set >= 2) return NLAT + (set - 2) * TC + p;
    return set * T + (p & 255) * 64 + (p >> 8);
}

__device__ __forceinline__ int winmap(int n) {
    if (n < 1152) return 1548 + n;
    if (n < 1176) return 3084 + (n - 1152);
    if (n < 1280) return -1;
    if (n < 2828) return n - 1280;
    if (n < 3212) return 2700 + (n - 2828);
    return -1;
}

constexpr int P0_NWIN = NL * 52 * 16, P0_NWOUT = NL * 16 * 16, P0_NADA = NL * (6144 / 32);
constexpr int P0_UNITS = P0_NWIN + P0_NWOUT + P0_NADA;

__device__ __forceinline__ void phase0(const Params& p, LAS unsigned char* lds) {
    const int tid = LTID;
    LAS float* tile = (LAS float*)lds;
    LAS float* tile2 = tile + 64 * 65;
    bf16_t* WinT = (bf16_t*)(p.ws + WS_WIN);
    bf16_t* WoutT = (bf16_t*)(p.ws + WS_WOUT);
    float* MOD = (float*)(p.ws + WS_MOD);
    for (int it = 0; it < PADDED_ITERS(P0_NWIN); ++it) { int u = VB + it * NVB; if (u >= P0_NWIN) u = P0_NWIN - 1;
        {
            const int l = u / 832, r = u % 832, nt = r / 16, kt = r % 16;
            const float* src = p.w_in + (size_t)l * D * IN_DIM;
            for (int e = tid; e < 1024; e += NTHR) { const int k = e >> 4, n = (e & 15) * 4; const int gn = winmap(nt * 64 + n);
                f32x4 v4 = (f32x4){0.f, 0.f, 0.f, 0.f};
                if (gn >= 0) v4 = *(const f32x4*)(src + (size_t)(kt * 64 + k) * IN_DIM + gn);
                tile[k * 65 + n] = v4[0]; tile[k * 65 + n + 1] = v4[1]; tile[k * 65 + n + 2] = v4[2]; tile[k * 65 + n + 3] = v4[3]; }
            __syncthreads();
            { const int n = tid >> 2, k0 = (tid & 3) * 16; u32x4 w0, w1; float f[16];
#pragma unroll
              for (int j = 0; j < 16; ++j) f[j] = tile[(k0 + j) * 65 + n];
              w0.x = pk2(f[0], f[1]); w0.y = pk2(f[2], f[3]); w0.z = pk2(f[4], f[5]); w0.w = pk2(f[6], f[7]);
              w1.x = pk2(f[8], f[9]); w1.y = pk2(f[10], f[11]); w1.z = pk2(f[12], f[13]); w1.w = pk2(f[14], f[15]);
              bf16_t* dst = WinT + (size_t)l * NPAD * D + kb_off(nt * 64 + n, kt * 64 + k0, NPAD);
              *(u32x4*)dst = w0; *(u32x4*)(dst + 8) = w1; }
            __syncthreads();
        }
    }
    for (int it = 0; it < PADDED_ITERS(P0_NWOUT); ++it) { int v = VB + it * NVB; if (v >= P0_NWOUT) v = P0_NWOUT - 1;
        {
            const int l = v / 256, r = v % 256, nt = r / 16, kt = r % 16;
            const float* src = p.w_out + (size_t)l * D * D;
            for (int e = tid; e < 1024; e += NTHR) { const int k = e >> 4, n = (e & 15) * 4; const f32x4 v4 = *(const f32x4*)(src + (size_t)(kt * 64 + k) * D + nt * 64 + n);
                tile[k * 65 + n] = v4[0]; tile[k * 65 + n + 1] = v4[1]; tile[k * 65 + n + 2] = v4[2]; tile[k * 65 + n + 3] = v4[3]; }
            if (kt < 4) {
                const float* pw = p.pool_w + ((size_t)l * 4 + kt) * 4096; const float* ps = p.pool_scale + l * 256 + kt * 64;
                for (int e = tid; e < 4096; e += NTHR) { const int c = e >> 6, d = e & 63; tile2[c * 65 + d] = pw[c * 64 + d] * ps[d]; }
            }
            __syncthreads();
            float acc[16];
            const int nn = tid & 63, c0 = (tid >> 6) * 16;
            if (kt < 4) {
#pragma unroll
                for (int j = 0; j < 16; ++j) acc[j] = 0.f;
                for (int d = 0; d < 64; ++d) { const float w = tile[d * 65 + nn];
#pragma unroll
                    for (int j = 0; j < 16; ++j) acc[j] += tile2[(c0 + j) * 65 + d] * w; }
            }
            __syncthreads();
            if (kt < 4) {
#pragma unroll
                for (int j = 0; j < 16; ++j) tile[(c0 + j) * 65 + nn] = acc[j];
            }
            __syncthreads();
            { const int n = tid >> 2, k0 = (tid & 3) * 16; u32x4 w0, w1; float f[16];
#pragma unroll
              for (int j = 0; j < 16; ++j) f[j] = tile[(k0 + j) * 65 + n];
              w0.x = pk2(f[0], f[1]); w0.y = pk2(f[2], f[3]); w0.z = pk2(f[4], f[5]); w0.w = pk2(f[6], f[7]);
              w1.x = pk2(f[8], f[9]); w1.y = pk2(f[10], f[11]); w1.z = pk2(f[12], f[13]); w1.w = pk2(f[14], f[15]);
              bf16_t* dst = WoutT + (size_t)l * D * D + kb_off(nt * 64 + n, kt * 64 + k0, D);
              *(u32x4*)dst = w0; *(u32x4*)(dst + 8) = w1; }
            __syncthreads();
        }
    }
    for (int it = 0; it < PADDED_ITERS(P0_NADA); ++it) { int v = VB + it * NVB; if (v >= P0_NADA) v = P0_NADA - 1;
        {
            const int l = v / 192, cg = v % 192;
            const int col = cg * 32 + (tid & 31), kg = tid >> 5;
            const float* aw = p.ada_w + (size_t)l * D * 6144;
            LAS float* sv = tile2;
            for (int i = tid; i < 3 * D; i += NTHR) sv[i] = silu_f(i < 2 * D ? p.c[i] : p.c_ctx[i - 2 * D]);
            __syncthreads();
            float a0 = 0.f, a1 = 0.f, a2 = 0.f;
#pragma unroll 8
            for (int k = kg * 128; k < kg * 128 + 128; ++k) {
                const float w = aw[(size_t)k * 6144 + col];
                a0 += sv[k] * w; a1 += sv[D + k] * w; a2 += sv[2 * D + k] * w;
            }
            tile[(kg * 3 + 0) * 32 + (tid & 31)] = a0; tile[(kg * 3 + 1) * 32 + (tid & 31)] = a1; tile[(kg * 3 + 2) * 32 + (tid & 31)] = a2;
            __syncthreads();
            if (tid < 96) { const int s = tid >> 5, cc = tid & 31; float sum = p.ada_b[l * 6144 + cg * 32 + cc];
                for (int g = 0; g < 8; ++g) sum += tile[(g * 3 + s) * 32 + cc];
                MOD[((size_t)l * 3 + s) * 6144 + cg * 32 + cc] = sum; }
            __syncthreads();
        }
    }
}

__device__ __forceinline__ void load_row(const float* xr, int lane, float (&v)[16]) {
#pragma unroll
    for (int j = 0; j < 4; ++j) { const f32x4 t = *(const f32x4*)(xr + j * 256 + lane * 4); v[4 * j] = t[0]; v[4 * j + 1] = t[1]; v[4 * j + 2] = t[2]; v[4 * j + 3] = t[3]; }
}
__device__ __forceinline__ void norm_mod(const float (&v)[16], const float* g, const float* shift, const float* scale, int lane, float (&h)[16]) {
    float ss = 0.f;
#pragma unroll
    for (int j = 0; j < 16; ++j) ss += v[j] * v[j];
    ss = wave_sum(ss);
    const float rstd = rsqrtf(ss * (1.f / D) + EPS);
#pragma unroll
    for (int j = 0; j < 4; ++j) { const int c = j * 256 + lane * 4;
        const f32x4 gg = *(const f32x4*)(g + c), sh = *(const f32x4*)(shift + c), sc = *(const f32x4*)(scale + c);
#pragma unroll
        for (int e = 0; e < 4; ++e) h[4 * j + e] = v[4 * j + e] * rstd * gg[e] * (1.f + sc[e]) + sh[e]; }
}
__device__ __forceinline__ void store_row_bf16(bf16_t* hr, int lane, const float (&h)[16]) {
#pragma unroll
    for (int j = 0; j < 4; ++j) { u32x2 w; w.x = pk2(h[4 * j], h[4 * j + 1]); w.y = pk2(h[4 * j + 2], h[4 * j + 3]); *(u32x2*)(hr + j * 256 + lane * 4) = w; }
}

__device__ __forceinline__ void load_rows4(const float* xr, int lane, float (&v)[4][16]) {
#pragma unroll
    for (int r = 0; r < 4; ++r)
#pragma unroll
        for (int j = 0; j < 4; ++j) { const f32x4 t = *(const f32x4*)(xr + (size_t)r * D + j * 256 + lane * 4); v[r][4 * j] = t[0]; v[r][4 * j + 1] = t[1]; v[r][4 * j + 2] = t[2]; v[r][4 * j + 3] = t[3]; }
}
__device__ __forceinline__ void load_rows4_bf16(const bf16_t* xr, int lane, float (&v)[4][16]) {
    u32x2 w[4][4];
#pragma unroll
    for (int r = 0; r < 4; ++r)
#pragma unroll
        for (int j = 0; j < 4; ++j) w[r][j] = *(const u32x2*)(xr + (size_t)r * D + j * 256 + lane * 4);
#pragma unroll
    for (int r = 0; r < 4; ++r)
#pragma unroll
        for (int j = 0; j < 4; ++j) { v[r][4 * j] = __uint_as_float(w[r][j].x << 16); v[r][4 * j + 1] = __uint_as_float(w[r][j].x & 0xffff0000u); v[r][4 * j + 2] = __uint_as_float(w[r][j].y << 16); v[r][4 * j + 3] = __uint_as_float(w[r][j].y & 0xffff0000u); }
}
__device__ __forceinline__ void norm_mod4(float (&v)[4][16], const float* g, const float* shift, const float* scale, int lane) {
    float ss[4];
#pragma unroll
    for (int r = 0; r < 4; ++r) { float t = 0.f;
#pragma unroll
        for (int j = 0; j < 16; ++j) t += v[r][j] * v[r][j];
        ss[r] = t; }
#pragma unroll
    for (int o = 32; o > 0; o >>= 1) {
#pragma unroll
        for (int r = 0; r < 4; ++r) ss[r] += __shfl_xor(ss[r], o); }
    float rstd[4];
#pragma unroll
    for (int r = 0; r < 4; ++r) rstd[r] = rsqrtf(ss[r] * (1.f / D) + EPS);
#pragma unroll
    for (int j = 0; j < 4; ++j) { const int c = j * 256 + lane * 4;
        const f32x4 gg = *(const f32x4*)(g + c), sh = *(const f32x4*)(shift + c), sc = *(const f32x4*)(scale + c);
#pragma unroll
        for (int e = 0; e < 4; ++e) { const float a = gg[e] * (1.f + sc[e]);
#pragma unroll
            for (int r = 0; r < 4; ++r) v[r][4 * j + e] = v[r][4 * j + e] * rstd[r] * a + sh[e]; } }
}
__device__ __forceinline__ void store_rows4_bf16(bf16_t* base, size_t row0, int lane, const float (&h)[4][16]) {
#pragma unroll
    for (int r = 0; r < 4; ++r)
#pragma unroll
        for (int j = 0; j < 4; ++j) { u32x2 w; w.x = pk2(h[r][4 * j], h[r][4 * j + 1]); w.y = pk2(h[r][4 * j + 2], h[r][4 * j + 3]); *(u32x2*)(base + kb_off(row0 + r, j * 256 + lane * 4, NROWS)) = w; }
}

__device__ __forceinline__ void phase_norm1(const Params& p) {
    const int lane = LTID & 63, wv = __builtin_amdgcn_readfirstlane(LTID >> 6);
    bf16_t* H = (bf16_t*)(p.ws + WS_RA);
    const float* MOD = (const float*)(p.ws + WS_MOD);
    for (int u = VB; u < NROWS / 16; u += NVB) {
        const int row = u * 16 + wv * 4;
        const float* xr = row < NLAT ? p.x + (size_t)row * D : p.ctx + (size_t)(row - NLAT) * D;
        const float* m = MOD + (size_t)(0 * 3 + row_mset(row)) * 6144;
        float v[4][16]; load_rows4(xr, lane, v);
        norm_mod4(v, p.norm1_g, m, m + D, lane);
        store_rows4_bf16(H, (size_t)row, lane, v);
    }
}

#define PAIR16_COL(fq) (16 * ((fq) & 1) + 8 * ((fq) >> 1))
__device__ __forceinline__ u32x4 pack_pair16(float a0, float a1, float a2, float a3, float b0, float b1, float b2, float b3) {
    const unsigned pa0 = pk2(a0, a1), pa1 = pk2(a2, a3), pb0 = pk2(b0, b1), pb1 = pk2(b2, b3);
    const auto s0 = __builtin_amdgcn_permlane16_swap(pa0, pb0, false, false);
    const auto s1 = __builtin_amdgcn_permlane16_swap(pa1, pb1, false, false);
    return (u32x4){s0[0], s1[0], s0[1], s1[1]};
}

constexpr int GS_SLOT = 32768;
__device__ __forceinline__ int gs_g(int x) { return (0x78 >> (2 * x)) & 3; }
__device__ __forceinline__ int gs_srcchunk(int tid) { return ((tid & 3) ^ gs_g((tid >> 4) & 3)) * 8; }
template <int GRP, class Setup, class Epi>
__device__ __forceinline__ void gemm_stream_grp(LAS unsigned char* lds, int vb, int nvb, int nunits, int K, size_t ksa, size_t ksb, Setup&& setup, Epi&& epi) {
    const int tid = threadIdx.x, wid = __builtin_amdgcn_readfirstlane(tid >> 6), lane = tid & 63, wr = (wid >> 1) & 1, wcol = (wid >> 2) * 128 + (wid & 1) * 64, fr = lane & 15, fq = lane >> 4;
    const int xb = vb & 7, xslot = vb >> 3, xP = nvb >> 3;
    int xk = 0;
    int u = xb * xP + xslot;
    const int nt = K / 32;
    const bf16_t* ap[2]; const bf16_t* bp[2];
    setup(u, ap, bp);
    const unsigned ldsw = (unsigned)tid * 16u;
#define GS_STAGE(pa, pb, kt, slot) do { LAS unsigned char* s_ = lds + (slot) * GS_SLOT + ldsw; \
        _Pragma("unroll") for (int i_ = 0; i_ < 2; ++i_) __builtin_amdgcn_global_load_lds((const unsigned*)((pa)[i_] + (size_t)(kt) * ksa), (LAS unsigned*)(s_ + i_ * 8192), 16, 0, 0); \
        _Pragma("unroll") for (int i_ = 0; i_ < 2; ++i_) __builtin_amdgcn_global_load_lds((const unsigned*)((pb)[i_] + (size_t)(kt) * ksb), (LAS unsigned*)(s_ + 16384 + i_ * 8192), 16, 0, 0); } while (0)
#define GS_BARRIER() do { __builtin_amdgcn_sched_barrier(0); __builtin_amdgcn_s_barrier(); __builtin_amdgcn_sched_barrier(0); asm volatile("" ::: "memory"); } while (0)
#define GS_STAGE_NEXT(t_) do { if ((t_) + 3 < nt) GS_STAGE(ap, bp, (t_) + 3, ws); else if (has_next) { if ((t_) + 3 == nt) setup(un, ap, bp); GS_STAGE(ap, bp, (t_) + 3 - nt, ws); } } while (0)
#define GS_READ() do { \
        _Pragma("unroll") for (int m = 0; m < 8; ++m) af[m] = *(const LAS bf16x8*)(sl + aoff + m * 1024); \
        _Pragma("unroll") for (int n = 0; n < 4; ++n) bfr[n] = *(const LAS bf16x8*)(sl + boff + n * 1024); } while (0)
#define GS_MFMA() do { \
        _Pragma("unroll") for (int m = 0; m < 8; ++m) \
        _Pragma("unroll") for (int n = 0; n < 4; ++n) acc[m][n] = MFMA16(bfr[n], af[m], acc[m][n]); } while (0)
    GS_STAGE(ap, bp, 0, 0); GS_STAGE(ap, bp, 1, 1); GS_STAGE(ap, bp, 2, 2);
    int rs = 0;
    const int swc = (fq ^ gs_g(fr >> 2)) * 16;
    const int aoff = (wr * 128 + fr) * 64 + swc, boff = 16384 + (wcol + fr) * 64 + swc;
    f32x4 acc[8][4];
    bf16x8 af[8], bfr[4];
    if (GRP == 1) {
#pragma unroll
        for (int m = 0; m < 8; ++m) af[m] = (bf16x8)(0);
#pragma unroll
        for (int n = 0; n < 4; ++n) bfr[n] = (bf16x8)(0);
    }
    int upend = u; bool pend = false, have_cur = true;
    for (;;) {
        int un = u; bool has_next = false;
        if (have_cur) { un = ((xk + 1) * 8 + xb) * xP + xslot; has_next = un < nunits; }
        {
            const int t = 0;
            if (!have_cur) asm volatile("s_waitcnt vmcnt(0) lgkmcnt(0)" ::: "memory");
            else asm volatile("s_waitcnt vmcnt(8) lgkmcnt(0)" ::: "memory");
            GS_BARRIER();
            const int ws = (rs + 3) & 3;
            const LAS unsigned char* sl = lds + rs * GS_SLOT;
            if (GRP == 1) GS_MFMA();
            if (pend) { asm volatile("s_waitcnt vmcnt(0)" ::: "memory"); epi(upend, acc); }
            if (!have_cur) break;
#pragma unroll
            for (int m = 0; m < 8; ++m)
#pragma unroll
                for (int n = 0; n < 4; ++n) acc[m][n] = (f32x4){0.f, 0.f, 0.f, 0.f};
            if (GRP == 0) { GS_STAGE_NEXT(t); GS_READ(); }
            GS_BARRIER();
            if (GRP == 0) GS_MFMA();
            else { GS_STAGE_NEXT(t); GS_READ(); }
            rs = (rs + 1) & 3;
        }
#pragma clang loop unroll(disable)
        for (int t = 1; t < nt; ++t) {
            if (!has_next && t == nt - 1) asm volatile("s_waitcnt vmcnt(0) lgkmcnt(0)" ::: "memory");
            else if (!has_next && t == nt - 2) asm volatile("s_waitcnt vmcnt(4) lgkmcnt(0)" ::: "memory");
            else if (pend && t <= 2) asm volatile("s_waitcnt lgkmcnt(0)" ::: "memory");
            else asm volatile("s_waitcnt vmcnt(8) lgkmcnt(0)" ::: "memory");
            GS_BARRIER();
            const int ws = (rs + 3) & 3;
            const LAS unsigned char* sl = lds + rs * GS_SLOT;
            if (GRP == 1) GS_MFMA();
            if (GRP == 0) { GS_STAGE_NEXT(t); GS_READ(); }
            GS_BARRIER();
            if (GRP == 0) GS_MFMA();
            else { GS_STAGE_NEXT(t); GS_READ(); }
            rs = (rs + 1) & 3;
        }
        pend = true; upend = u;
        if (has_next) { u = un; ++xk; }
        else have_cur = false;
    }
#undef GS_STAGE
#undef GS_STAGE_NEXT
#undef GS_BARRIER
#undef GS_READ
#undef GS_MFMA
}
template <class Setup, class Epi>
__device__ __forceinline__ void gemm_stream(LAS unsigned char* lds, int vb, int nvb, int nunits, int K, size_t ksa, size_t ksb, Setup&& setup, Epi&& epi) {
    lds = opaque_lds(lds);
    const int grp = __builtin_amdgcn_readfirstlane((int)(threadIdx.x >> 8));
    if ((vb & 7) * (nvb >> 3) + (vb >> 3) < nunits && (vb >> 3) < (nvb >> 3)) {
        if (grp == 0) gemm_stream_grp<0>(lds, vb, nvb, nunits, K, ksa, ksb, setup, epi);
        else gemm_stream_grp<1>(lds, vb, nvb, nunits, K, ksa, ksb, setup, epi);
    }
    asm volatile("s_waitcnt vmcnt(0) lgkmcnt(0)" ::: "memory"); __builtin_amdgcn_s_barrier(); asm volatile("" ::: "memory");
}

__device__ __forceinline__ void tile_decode(int L, int MT, int NT, int& mt, int& nt) {
    const int R = L / (8 * NT), rem = L - R * 8 * NT; const int mrows = (MT - 8 * R) < 8 ? (MT - 8 * R) : 8;
    nt = rem / mrows; mt = 8 * R + (rem - nt * mrows);
}

#define GEMM_IDS const int tid = threadIdx.x, wid = __builtin_amdgcn_readfirstlane(tid >> 6), lane = tid & 63, wr = (wid >> 1) & 1, wcol = (wid >> 2) * 128 + (wid & 1) * 64, fr = lane & 15, fq = lane >> 4
constexpr int INP_XA = 112;
template <int PARTB>
__device__ __forceinline__ void inproj_unit(int u, int& mt, int& nt) {
    constexpr int MT = NROWS / 256;
    if (PARTB == 0) { if (u < MT * 5) tile_decode(u, MT, 5, mt, nt); else { mt = u - MT * 5; nt = 5; } }
    else { if (u < MT - INP_XA) { mt = INP_XA + u; nt = 5; } else { tile_decode(u - (MT - INP_XA), MT, 7, mt, nt); nt += 6; } }
}
template <int PARTB>
__device__ __forceinline__ void phase_inproj(const Params& p, int l, LAS unsigned char* lds, int vb, int nvb) {
    GEMM_IDS;
    const bf16_t* H = (const bf16_t*)(p.ws + WS_RA);
    const bf16_t* W = (const bf16_t*)(p.ws + WS_WIN) + (size_t)l * NPAD * D;
    bf16_t* P1 = (bf16_t*)(p.ws + WS_RB); bf16_t* P2 = (bf16_t*)((unsigned char*)p.out);
    constexpr int MT = NROWS / 256;
    gemm_stream(lds, vb, nvb, PARTB ? (MT - INP_XA) + MT * 7 : MT * 5 + INP_XA, D, (size_t)NROWS * 32, (size_t)NPAD * 32,
        [&](int u, const bf16_t* (&ap)[2], const bf16_t* (&bp)[2]) { int mt, nt; inproj_unit<PARTB>(u, mt, nt);
#pragma unroll
            for (int i = 0; i < 2; ++i) { ap[i] = H + (size_t)(mt * 256 + (tid >> 2) + 128 * i) * 32 + gs_srcchunk(tid);
                bp[i] = W + (size_t)(nt * 256 + (tid >> 2) + 128 * i) * 32 + gs_srcchunk(tid); } },
        [&](int u, f32x4 (&acc)[8][4]) { int mt, nt; inproj_unit<PARTB>(u, mt, nt);
#pragma unroll
            for (int m = 0; m < 8; ++m) {
                const size_t row = (size_t)mt * 256 + wr * 128 + m * 16 + fr;
#pragma unroll
                for (int n = 0; n < 4; n += 2) {
                    const int col = nt * 256 + wcol + n * 16 + PAIR16_COL(fq);
                    const u32x4 w = pack_pair16(acc[m][n][0], acc[m][n][1], acc[m][n][2], acc[m][n][3], acc[m][n + 1][0], acc[m][n + 1][1], acc[m][n + 1][2], acc[m][n + 1][3]);
                    if (col < 1152) *(u32x4*)(P2 + row * P2_LD + col) = w;
                    else if (col < 1176) { bf16_t* d = P1 + row * P1_LD + C_AR + (col - 1152); *(u32x2*)d = (u32x2){w[0], w[1]}; *(u32x2*)(d + 4) = (u32x2){w[2], w[3]}; }
                    else if (col >= 1280 && col + 8 <= 3212) *(u32x4*)(P1 + row * P1_LD + (col - 1280)) = w;
                    else if (col >= 1280 && col < 3212) *(u32x2*)(P1 + row * P1_LD + (col - 1280)) = (u32x2){w[0], w[1]};
                }
            } });
}

__device__ __forceinline__ void phase_outproj(const Params& p, int l, LAS unsigned char* lds) {
    GEMM_IDS;
    const bf16_t* MIX = (const bf16_t*)(p.ws + WS_RD);
    const bf16_t* W = (const bf16_t*)(p.ws + WS_WOUT) + (size_t)l * D * D;
    const float* MOD = (const float*)(p.ws + WS_MOD) + (size_t)l * 3 * 6144;
    bf16_t* XB = (bf16_t*)(p.ws + WS_XB);
    constexpr int MT = NLAT / 256;
    gemm_stream(lds, blockIdx.x, gridDim.x, MT * 4, D, (size_t)NROWS * 32, (size_t)D * 32,
        [&](int u, const bf16_t* (&ap)[2], const bf16_t* (&bp)[2]) { int mt, nt; tile_decode(u, MT, 4, mt, nt);
#pragma unroll
            for (int i = 0; i < 2; ++i) { ap[i] = MIX + (size_t)(mt * 256 + (tid >> 2) + 128 * i) * 32 + gs_srcchunk(tid);
                bp[i] = W + (size_t)(nt * 256 + (tid >> 2) + 128 * i) * 32 + gs_srcchunk(tid); } },
        [&](int u, f32x4 (&acc)[8][4]) { int mt, nt; tile_decode(u, MT, 4, mt, nt);
            const int row_t0 = mt * 256;
            const float* gate = MOD + (size_t)row_mset(row_t0) * 6144 + 2 * D;
#pragma unroll
            for (int m = 0; m < 8; ++m) {
                const int row = row_t0 + wr * 128 + m * 16 + fr;
                const float* src = row < NLAT ? p.x + (size_t)row * D : p.ctx + (size_t)(row - NLAT) * D;
                bf16_t* xb = XB + (size_t)row * D;
                f32x4 o[4];
#pragma unroll
                for (int n = 0; n < 4; ++n) {
                    const int col = nt * 256 + wcol + n * 16 + 4 * fq;
                    const f32x4 g = *(const f32x4*)(gate + col);
                    f32x4 xs;
                    if (l == 0) xs = *(const f32x4*)(src + col);
                    else { const u32x2 w = *(const u32x2*)(xb + col); xs[0] = __uint_as_float(w.x << 16); xs[1] = __uint_as_float(w.x & 0xffff0000u); xs[2] = __uint_as_float(w.y << 16); xs[3] = __uint_as_float(w.y & 0xffff0000u); }
                    o[n][0] = xs[0] + g[0] * acc[m][n][0]; o[n][1] = xs[1] + g[1] * acc[m][n][1]; o[n][2] = xs[2] + g[2] * acc[m][n][2]; o[n][3] = xs[3] + g[3] * acc[m][n][3];
                }
#pragma unroll
                for (int n = 0; n < 4; n += 2)
                    *(u32x4*)(xb + nt * 256 + wcol + n * 16 + PAIR16_COL(fq)) = pack_pair16(o[n][0], o[n][1], o[n][2], o[n][3], o[n + 1][0], o[n + 1][1], o[n + 1][2], o[n + 1][3]);
            } });
    if (l == 0) {
        float* PART = (float*)((unsigned char*)p.out + PART_OFF);
        gemm_stream(lds, blockIdx.x, gridDim.x, 8 * OP_KS, D / OP_KS, (size_t)NROWS * 32, (size_t)D * 32,
            [&](int u, const bf16_t* (&ap)[2], const bf16_t* (&bp)[2]) { const int ks = u & (OP_KS - 1), tl = u / OP_KS, mt = MT + (tl >> 2), nt = tl & 3;
#pragma unroll
                for (int i = 0; i < 2; ++i) { ap[i] = MIX + (size_t)ks * (D / OP_KS / 32) * NROWS * 32 + (size_t)(mt * 256 + (tid >> 2) + 128 * i) * 32 + gs_srcchunk(tid);
                    bp[i] = W + (size_t)ks * (D / OP_KS / 32) * D * 32 + (size_t)(nt * 256 + (tid >> 2) + 128 * i) * 32 + gs_srcchunk(tid); } },
            [&](int u, f32x4 (&acc)[8][4]) { const int ks = u & (OP_KS - 1), tl = u / OP_KS, mtc = tl >> 2, nt = tl & 3;
#pragma unroll
                for (int m = 0; m < 8; ++m) {
                    float* pr = PART + ((size_t)ks * (NB * TC) + mtc * 256 + wr * 128 + m * 16 + fr) * D + nt * 256 + wcol + 4 * fq;
#pragma unroll
                    for (int n = 0; n < 4; ++n) *(f32x4*)(pr + n * 16) = acc[m][n];
                } });
    }
}

constexpr int ER_LAT = NB * NE * CAP_L, ER_ALL = ER_LAT + NB * NE * CAP_C;
constexpr size_t W1T_BYTES = (size_t)NE * D * D * 2;
__device__ __forceinline__ void exp_unit(int u, int& g, int& nt, int& er0, int& mvalid) {
    if (u < 1024) { g = u >> 5; nt = (u >> 3) & 3; er0 = g * CAP_L + (u & 7) * 256; mvalid = 256; }
    else { const int v = u - 1024; g = v >> 2; nt = v & 3; er0 = ER_LAT + g * CAP_C; mvalid = CAP_C; }
}

__device__ __forceinline__ void phase_exp1(const Params& p, int l, LAS unsigned char* lds) {
    GEMM_IDS;
    const bf16_t* H2 = (const bf16_t*)(p.ws + WS_RA);
    const bf16_t* W1T = (const bf16_t*)((unsigned char*)p.out);
    bf16_t* HID = (bf16_t*)(p.ws + WS_RB);
    const int* SELROW = (const int*)(p.ws + WS_SELIDX);
    const int nunits = 1024 + ((l == NL - 1) ? 0 : 128);
    gemm_stream(lds, blockIdx.x, gridDim.x, nunits, D, (size_t)NROWS * 32, (size_t)D * 32,
        [&](int u, const bf16_t* (&ap)[2], const bf16_t* (&bp)[2]) { int g, nt, er0, mvalid; exp_unit(u, g, nt, er0, mvalid); const int e = g & 15;
#pragma unroll
            for (int i = 0; i < 2; ++i) { const int R = (tid >> 2) + 128 * i; ap[i] = H2 + (size_t)SELROW[er0 + (R < mvalid ? R : mvalid - 1)] * 32 + gs_srcchunk(tid);
                bp[i] = W1T + (size_t)e * D * D + (size_t)(nt * 256 + R) * 32 + gs_srcchunk(tid); } },
        [&](int u, f32x4 (&acc)[8][4]) { int g, nt, er0, mvalid; exp_unit(u, g, nt, er0, mvalid);
            const int grp = (nt * 256 + wcol) >> 6;
#pragma unroll
            for (int m = 0; m < 8; ++m) {
                const int r = wr * 128 + m * 16 + fr;
                if (r < mvalid) {
                    float h[2][4];
#pragma unroll
                    for (int n = 0; n < 2; ++n)
#pragma unroll
                        for (int q = 0; q < 4; ++q) h[n][q] = silu_f(acc[m][n][q]) * acc[m][n + 2][q];
                    *(u32x4*)(HID + kb_off((size_t)(er0 + r), grp * 32 + PAIR16_COL(fq), ER_ALL)) = pack_pair16(h[0][0], h[0][1], h[0][2], h[0][3], h[1][0], h[1][1], h[1][2], h[1][3]);
                }
            } });
}

__device__ __forceinline__ void phase_exp2(const Params& p, int l, LAS unsigned char* lds) {
    GEMM_IDS;
    const bf16_t* HID = (const bf16_t*)(p.ws + WS_RB);
    const bf16_t* W2T = (const bf16_t*)((unsigned char*)p.out + W1T_BYTES);
    bf16_t* YE = (bf16_t*)(p.ws + WS_RD);
    const float* SELGATE = (const float*)(p.ws + WS_SELGATE);
    const int nunits = 1024 + ((l == NL - 1) ? 0 : 128);
    gemm_stream(lds, blockIdx.x, gridDim.x, nunits, FF, (size_t)ER_ALL * 32, (size_t)D * 32,
        [&](int u, const bf16_t* (&ap)[2], const bf16_t* (&bp)[2]) { int g, nt, er0, mvalid; exp_unit(u, g, nt, er0, mvalid); const int e = g & 15;
#pragma unroll
            for (int i = 0; i < 2; ++i) { const int R = (tid >> 2) + 128 * i; ap[i] = HID + (size_t)(er0 + (R < mvalid ? R : mvalid - 1)) * 32 + gs_srcchunk(tid);
                bp[i] = W2T + (size_t)e * D * FF + (size_t)(nt * 256 + R) * 32 + gs_srcchunk(tid); } },
        [&](int u, f32x4 (&acc)[8][4]) { int g, nt, er0, mvalid; exp_unit(u, g, nt, er0, mvalid);
#pragma unroll
            for (int m = 0; m < 8; ++m) {
                const int r = wr * 128 + m * 16 + fr;
                if (r < mvalid) {
                    const float gt = SELGATE[er0 + r];
#pragma unroll
                    for (int n = 0; n < 4; n += 2)
                        *(u32x4*)(YE + (size_t)(er0 + r) * D + nt * 256 + wcol + n * 16 + PAIR16_COL(fq)) =
                            pack_pair16(acc[m][n][0] * gt, acc[m][n][1] * gt, acc[m][n][2] * gt, acc[m][n][3] * gt, acc[m][n + 1][0] * gt, acc[m][n + 1][1] * gt, acc[m][n + 1][2] * gt, acc[m][n + 1][3] * gt);
                }
            } });
}

__device__ __forceinline__ void phase_norm2_router(const Params& p, int l, LAS unsigned char* lds) {
    const int tid = LTID, lane = tid & 63, wv = __builtin_amdgcn_readfirstlane(tid >> 6);
    LAS float* RW = (LAS float*)lds;
    if (l == 0) {
        const float* MODg = (const float*)(p.ws + WS_MOD);
        for (int u = VB; u < NROWS / 16; u += NVB) {
            const int row = u * 16 + wv * 4;
            if (row < NLAT) continue;
            const float* g1 = MODg + (size_t)row_mset(row) * 6144 + 2 * D;
            float h[4][16];
            load_rows4(p.ctx + (size_t)(row - NLAT) * D, lane, h);
            const float* PART = (const float*)((const unsigned char*)p.out + PART_OFF) + (size_t)(row - NLAT) * D;
#pragma clang loop unroll(disable)
            for (int ks = 0; ks < OP_KS; ++ks) {
#pragma unroll
                for (int j = 0; j < 4; ++j) { const f32x4 g = *(const f32x4*)(g1 + j * 256 + lane * 4);
#pragma unroll
                    for (int r = 0; r < 4; ++r) { const f32x4 t = *(const f32x4*)(PART + ((size_t)ks * (NB * TC) + r) * D + j * 256 + lane * 4);
                        h[r][4 * j] += g[0] * t[0]; h[r][4 * j + 1] += g[1] * t[1]; h[r][4 * j + 2] += g[2] * t[2]; h[r][4 * j + 3] += g[3] * t[3]; } }
                asm volatile("" ::: "memory");
            }
            bf16_t* xw = (bf16_t*)(p.ws + WS_XB) + (size_t)row * D;
#pragma unroll
            for (int r = 0; r < 4; ++r)
#pragma unroll
                for (int j = 0; j < 4; ++j) { u32x2 w; w.x = pk2(h[r][4 * j], h[r][4 * j + 1]); w.y = pk2(h[r][4 * j + 2], h[r][4 * j + 3]); *(u32x2*)(xw + (size_t)r * D + j * 256 + lane * 4) = w; }
        }
    }
    { const float* rw = p.router_w + (size_t)l * D * NE;
      for (int i = tid; i < D * NE / 4; i += NTHR) { const int c = i >> 2, q = i & 3; *(LAS f32x4*)(RW + (((q * 4 + (c & 3)) * 256 + (c >> 2)) * 4)) = *(const f32x4*)(rw + i * 4); }
      __syncthreads(); }
    bf16_t* H2 = (bf16_t*)(p.ws + WS_RA);
    const float* MOD = (const float*)(p.ws + WS_MOD) + (size_t)l * 3 * 6144;
    const bf16_t* XB = (const bf16_t*)(p.ws + WS_XB);
    float* AFF = (float*)(p.ws + WS_AFF);
    const int nrows = (l == NL - 1) ? NLAT : NROWS;
    u32x2 nx[4][4];
#define N2_LOAD(uu) do { const bf16_t* xr_ = XB + (size_t)((uu) * 16 + wv * 4) * D; \
        _Pragma("unroll") for (int r = 0; r < 4; ++r) _Pragma("unroll") for (int j = 0; j < 4; ++j) nx[r][j] = *(const u32x2*)(xr_ + (size_t)r * D + j * 256 + lane * 4); } while (0)
    if (VB < nrows / 16) N2_LOAD(VB);
    for (int u = VB; u < nrows / 16; u += NVB) {
        const int row = u * 16 + wv * 4;
        const float* m = MOD + (size_t)row_mset(row) * 6144;
        float h[4][16];
#pragma unroll
        for (int r = 0; r < 4; ++r)
#pragma unroll
            for (int j = 0; j < 4; ++j) { h[r][4 * j] = __uint_as_float(nx[r][j].x << 16); h[r][4 * j + 1] = __uint_as_float(nx[r][j].x & 0xffff0000u); h[r][4 * j + 2] = __uint_as_float(nx[r][j].y << 16); h[r][4 * j + 3] = __uint_as_float(nx[r][j].y & 0xffff0000u); }
        if (u + NVB < nrows / 16) N2_LOAD(u + NVB);
        norm_mod4(h, p.norm2_g + l * D, m + 3 * D, m + 4 * D, lane);
        store_rows4_bf16(H2, (size_t)row, lane, h);
        float lg[4][16];
#pragma unroll
        for (int r = 0; r < 4; ++r)
#pragma unroll
            for (int e = 0; e < 16; ++e) lg[r][e] = 0.f;
#pragma unroll
        for (int j = 0; j < 16; ++j) {
            const LAS f32x4* wr4 = (const LAS f32x4*)RW + ((j & 3) * 256 + (j >> 2) * 64 + lane);
            const f32x4 w0 = wr4[0], w1 = wr4[1024], w2 = wr4[2048], w3 = wr4[3072];
#pragma unroll
            for (int r = 0; r < 4; ++r)
#pragma unroll
                for (int e = 0; e < 4; ++e) { lg[r][e] += h[r][j] * w0[e]; lg[r][4 + e] += h[r][j] * w1[e]; lg[r][8 + e] += h[r][j] * w2[e]; lg[r][12 + e] += h[r][j] * w3[e]; }
            if ((j & 1) == 1) asm volatile("" ::: "memory");
        }
        float z[4];
#pragma unroll
        for (int r = 0; r < 4; ++r) {
#pragma unroll
            for (int i = 0; i < 8; ++i) { const bool up = lane & 32; const float send = up ? lg[r][i] : lg[r][i + 8]; const float recv = __shfl_xor(send, 32); lg[r][i] = (up ? lg[r][i + 8] : lg[r][i]) + recv; }
#pragma unroll
            for (int i = 0; i < 4; ++i) { const bool up = lane & 16; const float send = up ? lg[r][i] : lg[r][i + 4]; const float recv = __shfl_xor(send, 16); lg[r][i] = (up ? lg[r][i + 4] : lg[r][i]) + recv; }
#pragma unroll
            for (int i = 0; i < 2; ++i) { const bool up = lane & 8; const float send = up ? lg[r][i] : lg[r][i + 2]; const float recv = __shfl_xor(send, 8); lg[r][i] = (up ? lg[r][i + 2] : lg[r][i]) + recv; }
            { const bool up = lane & 4; const float send = up ? lg[r][0] : lg[r][1]; const float recv = __shfl_xor(send, 4); lg[r][0] = (up ? lg[r][1] : lg[r][0]) + recv; }
            float zz = lg[r][0]; zz += __shfl_xor(zz, 2); zz += __shfl_xor(zz, 1); z[r] = zz;
        }
        const int e = ((lane >> 5) & 1) * 8 + ((lane >> 4) & 1) * 4 + ((lane >> 3) & 1) * 2 + ((lane >> 2) & 1);
#pragma unroll
        for (int r = 0; r < 4; ++r) {
            float mx = z[r];
            mx = fmaxf(mx, __shfl_xor(mx, 4)); mx = fmaxf(mx, __shfl_xor(mx, 8)); mx = fmaxf(mx, __shfl_xor(mx, 16)); mx = fmaxf(mx, __shfl_xor(mx, 32));
            const float ex = __expf(z[r] - mx);
            float sm = ex; sm += __shfl_xor(sm, 4); sm += __shfl_xor(sm, 8); sm += __shfl_xor(sm, 16); sm += __shfl_xor(sm, 32);
            const float a = ex / sm;
            if ((lane & 3) == 0) {
                const int rr = row + r;
                if (rr < NLAT) { const int b = rr / T, t = rr % T; AFF[((size_t)b * NE + e) * T + t] = a; }
                else { const int q = rr - NLAT, b = q / TC, t = q % TC; AFF[(size_t)NB * NE * T + ((size_t)b * NE + e) * TC + t] = a; }
            }
        }
    }
#undef N2_LOAD
    __syncthreads();
}

__device__ __forceinline__ int block_excl_scan(int v, LAS int* sc  , int& total) {
    const int lane = LTID & 63, wv = __builtin_amdgcn_readfirstlane(LTID >> 6);
    int x = v;
#pragma unroll
    for (int o = 1; o < 64; o <<= 1) { const int y = __shfl_up(x, o); if (lane >= o) x += y; }
    __syncthreads();
    if (lane == 63) sc[wv] = x;
    __syncthreads();
    int base = 0, tot = 0;
#pragma unroll
    for (int w = 0; w < 4; ++w) { const int s = sc[w]; if (w < wv) base += s; tot += s; }
    total = tot;
    return base + x - v;
}

constexpr int TK_CONV_UNITS = 4096 + 2048;
__device__ __forceinline__ void phase_topk_conv(const Params& p, int l, LAS unsigned char* lds) {
    const int tid = LTID;
    const int n_tk = 64;
    const float* AFF = (const float*)(p.ws + WS_AFF);
    int* SELROW = (int*)(p.ws + WS_SELIDX); float* SELGATE = (float*)(p.ws + WS_SELGATE); int* SLOT = (int*)(p.ws + WS_SLOT);
    bf16_t* W1T = (bf16_t*)((unsigned char*)p.out); bf16_t* W2T = (bf16_t*)((unsigned char*)p.out + W1T_BYTES);
    if ((int)blockIdx.x * 2 < n_tk) {
        { const int u = VB;
            const int isctx = u & 1, g = u >> 1, b = g >> 4, e = g & 15;
            const int N = isctx ? ((l == NL - 1) ? 0 : TC) : T, KSEL = N / 8;
            const float* src = isctx ? AFF + (size_t)NB * NE * T + (size_t)g * TC : AFF + (size_t)g * T;
            const int rowbase = isctx ? NLAT + b * TC : b * T;
            const int er0 = isctx ? ER_LAT + g * CAP_C : g * CAP_L;
#define VP(n) ((n) + ((n) >> 6))
            LAS unsigned* VAL = (LAS unsigned*)lds;
            LAS int* HIST = (LAS int*)(lds + 66560);
            LAS int* SC = HIST + 1024;
            const int wvl = tid >> 6;
            for (int i = tid; i < N; i += NTHR) VAL[VP(i)] = __float_as_uint(src[i]);
            unsigned prefix = 0u, pmask = 0u; int kk = KSEL;
            for (int shift = 24; shift >= 0; shift -= 8) {
                HIST[tid] = 0; HIST[256 + tid] = 0; HIST[512 + tid] = 0; HIST[768 + tid] = 0;
                __syncthreads();
                for (int i = tid; i < N; i += NTHR) { const unsigned v = VAL[VP(i)]; if ((v & pmask) == prefix) atomicAdd((int*)&HIST[wvl * 256 + ((v >> shift) & 255u)], 1); }
                __syncthreads();
                const int hv = HIST[255 - tid] + HIST[256 + 255 - tid] + HIST[512 + 255 - tid] + HIST[768 + 255 - tid]; int tot;
                const int above = block_excl_scan(hv, SC, tot);
                if (above < kk && kk <= above + hv) { SC[8] = 255 - tid; SC[9] = kk - above; }
                __syncthreads();
                prefix |= ((unsigned)SC[8]) << shift; pmask |= 255u << shift; kk = SC[9];
                __syncthreads();
            }
            const int per = N / NTHR, i0 = tid * per;
            int ngt = 0, neq = 0;
            for (int i = 0; i < per; ++i) { const unsigned v = VAL[VP(i0 + i)]; ngt += v > prefix; neq += v == prefix; }
            int tot;
            const int eqbase = block_excl_scan(neq, SC, tot);
            int ntake = ngt; { int er = eqbase; for (int i = 0; i < per; ++i) { const unsigned v = VAL[VP(i0 + i)]; if (v == prefix) { ntake += er < kk; ++er; } } }
            int pos = block_excl_scan(ntake, SC, tot);
            { int er = eqbase;
              for (int i = 0; i < per; ++i) { const unsigned v = VAL[VP(i0 + i)]; bool take = v > prefix;
                  if (v == prefix) { take = er < kk; ++er; }
                  const int row = rowbase + i0 + i;
                  int sl = -1;
                  if (take) { SELROW[er0 + pos] = row; SELGATE[er0 + pos] = __uint_as_float(v); sl = er0 + pos; ++pos; }
                  VAL[VP(i0 + i)] = (unsigned)sl; } }
            __syncthreads();
            for (int i = tid; i < N; i += NTHR) SLOT[(size_t)e * NROWS + rowbase + i] = (int)VAL[VP(i)];
#undef VP
            __syncthreads();
        }
    }
    const int nvc = NVB - n_tk, vbc = VB - n_tk;
    if (vbc >= 0)
    for (int it = 0; it < (TK_CONV_UNITS + nvc - 1) / nvc; ++it) { int v = vbc + it * nvc; if (v >= TK_CONV_UNITS) v = TK_CONV_UNITS - 1;
        {
            LAS float* tile = (LAS float*)lds;
            const float* src; size_t sld; bf16_t* dst; int dk0 = 0, dn0 = 0;
            int nrow_map_gate = -1;
            int grp0 = 0;
            if (v < 4096) {
                const int isup = v >> 11, w = v & 2047, e = w >> 7, kt = (w >> 3) & 15, ft = w & 7;
                src = (isup ? p.exp_w_up : p.exp_w_gate) + (((size_t)l * NE + e) * D + kt * 64) * FF + ft * 64; sld = FF;
                dst = W1T + (size_t)e * D * D; dk0 = kt * 64; dn0 = 0; nrow_map_gate = isup; grp0 = ft * 2;
            } else {
                const int w = v - 4096, e = w >> 7, ft = (w >> 4) & 7, nt = w & 15;
                src = p.exp_w_down + (((size_t)l * NE + e) * FF + ft * 64) * D + nt * 64; sld = D;
                dst = W2T + (size_t)e * D * FF; dk0 = ft * 64; dn0 = nt * 64;
            }
            for (int q = tid; q < 1024; q += NTHR) { const int k = q >> 4, n = (q & 15) * 4; const f32x4 v4 = *(const f32x4*)(src + (size_t)k * sld + n);
                tile[k * 65 + n] = v4[0]; tile[k * 65 + n + 1] = v4[1]; tile[k * 65 + n + 2] = v4[2]; tile[k * 65 + n + 3] = v4[3]; }
            __syncthreads();
            { const int n = tid >> 2, k0 = (tid & 3) * 16; u32x4 w0, w1; float f[16];
#pragma unroll
              for (int j = 0; j < 16; ++j) f[j] = tile[(k0 + j) * 65 + n];
              w0.x = pk2(f[0], f[1]); w0.y = pk2(f[2], f[3]); w0.z = pk2(f[4], f[5]); w0.w = pk2(f[6], f[7]);
              w1.x = pk2(f[8], f[9]); w1.y = pk2(f[10], f[11]); w1.z = pk2(f[12], f[13]); w1.w = pk2(f[14], f[15]);
              size_t drow;
              if (nrow_map_gate < 0) drow = (size_t)(dn0 + n);
              else drow = (size_t)(grp0 + (n >> 5)) * 64 + nrow_map_gate * 32 + (n & 31);
              bf16_t* d = dst + kb_off(drow, dk0 + k0, D);
              *(u32x4*)d = w0; *(u32x4*)(d + 8) = w1; }
            __syncthreads();
        }
    }
}

__device__ __forceinline__ void phase_combine(const Params& p, int l) {
    const int lane = LTID & 63, wv = __builtin_amdgcn_readfirstlane(LTID >> 6);
    const bf16_t* YE = (const bf16_t*)(p.ws + WS_RD);
    const int* SLOT = (const int*)(p.ws + WS_SLOT);
    const float* MOD = (const float*)(p.ws + WS_MOD);
    bf16_t* XB = (bf16_t*)(p.ws + WS_XB);
    bf16_t* H = (bf16_t*)(p.ws + WS_RA);
    const bool last = (l == NL - 1);
    const int nrows = last ? NLAT : NROWS;
    for (int u = VB; u < nrows / 16; u += NVB) {
        const int row = u * 16 + wv * 4;
        bf16_t* xr = XB + (size_t)row * D;
        const int ms = row_mset(row);
        const float* m = MOD + ((size_t)l * 3 + ms) * 6144;
        const int myslot = SLOT[(size_t)(lane & 15) * NROWS + row + (lane >> 4)];
        float v[4][16], acc[4][16];
        load_rows4_bf16(xr, lane, v);
        const unsigned long long act = __ballot(myslot >= 0);
#pragma unroll
        for (int r = 0; r < 4; ++r)
#pragma unroll
            for (int j = 0; j < 16; ++j) acc[r][j] = 0.f;
        unsigned mk0 = (unsigned)(act & 0xffffull), mk1 = (unsigned)((act >> 16) & 0xffffull), mk2 = (unsigned)((act >> 32) & 0xffffull), mk3 = (unsigned)((act >> 48) & 0xffffull);
        while (mk0 | mk1 | mk2 | mk3) {
            int sl[4]; float wt[4];
#define CB_TAKE(r, mk) do { \
                const int e0_ = mk ? (__ffs(mk) - 1) : 0; wt[r] = mk ? 1.f : 0.f; mk &= mk - 1; \
                const int a0_ = __shfl(myslot, 16 * r + e0_); sl[r] = (wt[r] != 0.f) ? a0_ : 0; } while (0)
            CB_TAKE(0, mk0); CB_TAKE(1, mk1); CB_TAKE(2, mk2); CB_TAKE(3, mk3);
#undef CB_TAKE
            u32x2 ya[4][4];
#pragma unroll
            for (int r = 0; r < 4; ++r) { const bf16_t* yr = YE + (size_t)sl[r] * D;
#pragma unroll
                for (int j = 0; j < 4; ++j) ya[r][j] = *(const u32x2*)(yr + j * 256 + lane * 4); }
#pragma unroll
            for (int r = 0; r < 4; ++r) { const float w = wt[r];
#pragma unroll
                for (int j = 0; j < 4; ++j) {
                    acc[r][4 * j] += w * __uint_as_float(ya[r][j].x << 16); acc[r][4 * j + 1] += w * __uint_as_float(ya[r][j].x & 0xffff0000u);
                    acc[r][4 * j + 2] += w * __uint_as_float(ya[r][j].y << 16); acc[r][4 * j + 3] += w * __uint_as_float(ya[r][j].y & 0xffff0000u); } }
        }
#pragma unroll
        for (int j = 0; j < 4; ++j) { const f32x4 g = *(const f32x4*)(m + 5 * D + j * 256 + lane * 4);
#pragma unroll
            for (int e = 0; e < 4; ++e)
#pragma unroll
                for (int r = 0; r < 4; ++r) v[r][4 * j + e] += g[e] * acc[r][4 * j + e]; }
        if (!last) {
#pragma unroll
            for (int r = 0; r < 4; ++r)
#pragma unroll
                for (int j = 0; j < 4; ++j) { u32x2 w; w.x = pk2(v[r][4 * j], v[r][4 * j + 1]); w.y = pk2(v[r][4 * j + 2], v[r][4 * j + 3]); *(u32x2*)(xr + (size_t)r * D + j * 256 + lane * 4) = w; }
            const float* m2 = MOD + ((size_t)(l + 1) * 3 + ms) * 6144;
            norm_mod4(v, p.norm1_g + (l + 1) * D, m2, m2 + D, lane);
            store_rows4_bf16(H, (size_t)row, lane, v);
        } else {
            float ss[4];
#pragma unroll
            for (int r = 0; r < 4; ++r) { float t = 0.f;
#pragma unroll
                for (int j = 0; j < 16; ++j) t += v[r][j] * v[r][j];
                ss[r] = t; }
#pragma unroll
            for (int o = 32; o > 0; o >>= 1) {
#pragma unroll
                for (int r = 0; r < 4; ++r) ss[r] += __shfl_xor(ss[r], o); }
#pragma unroll
            for (int j = 0; j < 4; ++j) { const f32x4 g = *(const f32x4*)(p.final_norm_g + j * 256 + lane * 4);
#pragma unroll
                for (int r = 0; r < 4; ++r) { const float rstd = rsqrtf(ss[r] * (1.f / D) + EPS);
                    *(f32x4*)(p.out + (size_t)(row + r) * D + j * 256 + lane * 4) = (f32x4){v[r][4 * j] * rstd * g[0], v[r][4 * j + 1] * rstd * g[1], v[r][4 * j + 2] * rstd * g[2], v[r][4 * j + 3] * rstd * g[3]}; } }
        }
    }
}

__device__ __forceinline__ void unpack4(const u32x2 w, float (&f)[4]) {
    f[0] = __uint_as_float(w.x << 16); f[1] = __uint_as_float(w.x & 0xffff0000u); f[2] = __uint_as_float(w.y << 16); f[3] = __uint_as_float(w.y & 0xffff0000u);
}
__device__ __forceinline__ void phase_post_tok(const Params& p, int l) {
    const int lane = LTID & 63, wv = __builtin_amdgcn_readfirstlane(LTID >> 6);
    const bf16_t* P1 = (const bf16_t*)(p.ws + WS_RB);
    const bf16_t* O = (const bf16_t*)((unsigned char*)p.out);
    bf16_t* MIX = (bf16_t*)(p.ws + WS_RD);
    const float* SSQP = (const float*)(p.ws + WS_SSQP);
    const bf16_t* YS = (const bf16_t*)((unsigned char*)p.out) + (size_t)2 * NROWS * 384;
    const bool last = (l == NL - 1);
    const int nrows = last ? NLAT : NROWS;
    for (int u = VB; u < nrows / 16; u += NVB) {
        const int row = u * 16 + wv * 4;
        int base, t0, N;
        if (row < NLAT) { base = (row / T) * T; t0 = row % T; N = T; } else { const int q = row - NLAT; base = NLAT + (q / TC) * TC; t0 = q % TC; N = TC; }
        {
            const int half = 1 << (lane >> 4);
            float sum[4][4];
#pragma unroll
            for (int r = 0; r < 4; ++r)
#pragma unroll
                for (int e = 0; e < 4; ++e) sum[r][e] = 0.f;
            u32x2 src[20];
#pragma unroll
            for (int k = 0; k < 20; ++k) { const int tt = t0 - 8 + k;
                src[k] = (tt >= 0 && tt < N && (k >= 8 - half) && (k < 11 + half + 1)) ? *(const u32x2*)(P1 + (size_t)(base + tt) * P1_LD + C_U + lane * 4) : (u32x2){0u, 0u}; }
#pragma unroll
            for (int k = 0; k < 20; ++k) { float f[4]; unpack4(src[k], f);
#pragma unroll
                for (int r = 0; r < 4; ++r) { const int d = k - 8 - r;
                    if (d >= -8 && d < 8) { const bool in = (d >= -half) && (d < half);
#pragma unroll
                        for (int e = 0; e < 4; ++e) sum[r][e] += in ? f[e] : 0.f; } } }
#pragma unroll
            for (int r = 0; r < 4; ++r) { const int t = t0 + r;
                const int lo = max(t - half, 0), hi = min(t + half, N);
                const float inv = 1.f / (float)(hi - lo);
                float c[4]; unpack4(src[8 + r], c);
                u32x2 o; o.x = pk2(sum[r][0] * inv - c[0], sum[r][1] * inv - c[1]); o.y = pk2(sum[r][2] * inv - c[2], sum[r][3] * inv - c[3]);
                *(u32x2*)(MIX + kb_off((size_t)(row + r), lane * 4, NROWS)) = o; }
        }
        {
            const float* ng = p.ssd_norm_g + l * 384;
            const f32x4 g0 = *(const f32x4*)(ng + lane * 4), g1 = *(const f32x4*)(ng + 256 + (lane & 31) * 4);
            float ss[4]; u32x2 w0[4], w1[4];
#pragma unroll
            for (int r = 0; r < 4; ++r) { ss[r] = lane < 24 ? SSQP[(size_t)(row + r) * 24 + lane] : 0.f;
                w0[r] = *(const u32x2*)(YS + (size_t)(row + r) * 384 + lane * 4);
                w1[r] = *(const u32x2*)(YS + (size_t)(row + r) * 384 + 256 + (lane & 31) * 4); }
#pragma unroll
            for (int o = 32; o > 0; o >>= 1) {
#pragma unroll
                for (int r = 0; r < 4; ++r) ss[r] += __shfl_xor(ss[r], o); }
#pragma unroll
            for (int r = 0; r < 4; ++r) { const float rstd = rsqrtf(ss[r] * (1.f / 384.f) + EPS);
                float f[4]; unpack4(w0[r], f);
                u32x2 o; o.x = pk2(f[0] * rstd * g0[0], f[1] * rstd * g0[1]); o.y = pk2(f[2] * rstd * g0[2], f[3] * rstd * g0[3]);
                *(u32x2*)(MIX + kb_off((size_t)(row + r), 256 + lane * 4, NROWS)) = o;
                unpack4(w1[r], f);
                o.x = pk2(f[0] * rstd * g1[0], f[1] * rstd * g1[1]); o.y = pk2(f[2] * rstd * g1[2], f[3] * rstd * g1[3]);
                if (lane < 32) *(u32x2*)(MIX + kb_off((size_t)(row + r), 512 + lane * 4, NROWS)) = o; }
        }
        {
            const f32x4 ng = *(const f32x4*)(p.gdn_norm_g + l * 64 + (lane & 15) * 4);
            u32x2 of0[4], ob0[4], gt0[4], of1[4], ob1[4], gt1[4];
            const int c1 = 256 + (lane & 31) * 4;
            const int h0 = lane >> 4, h1 = 4 + ((lane & 31) >> 4), vv = (lane & 15) * 4;
#pragma unroll
            for (int r = 0; r < 4; ++r) { const size_t rr = (size_t)(row + r);
                size_t ocl;
                { const int rw = row + r;
                  if (rw < NLAT) { const int bb = rw / T, tt = rw % T; const int pp = (tt & 63) * 256 + (tt >> 6); ocl = (size_t)((bb * 256 + (pp >> 6)) * 6) * 4096 + (pp & 63) * 64; }
                  else { const int q = rw - NLAT; ocl = (size_t)((512 + (q >> 6)) * 6) * 4096 + (q & 63) * 64; } }
                of0[r] = *(const u32x2*)(O + ocl + h0 * 4096 + vv); ob0[r] = *(const u32x2*)(O + (size_t)NCHUNK * 6 * 4096 + ocl + h0 * 4096 + vv);
                gt0[r] = *(const u32x2*)(P1 + rr * P1_LD + C_GATE + lane * 4);
                of1[r] = *(const u32x2*)(O + ocl + h1 * 4096 + vv); ob1[r] = *(const u32x2*)(O + (size_t)NCHUNK * 6 * 4096 + ocl + h1 * 4096 + vv);
                gt1[r] = *(const u32x2*)(P1 + rr * P1_LD + C_GATE + c1); }
#pragma unroll
            for (int r = 0; r < 4; ++r) { const size_t rr = (size_t)(row + r);
                float a[4], b[4], g[4], o[4];
                unpack4(of0[r], a); unpack4(ob0[r], b); unpack4(gt0[r], g);
                float ss = 0.f;
#pragma unroll
                for (int e = 0; e < 4; ++e) { o[e] = a[e] + b[e]; ss += o[e] * o[e]; }
                ss += __shfl_xor(ss, 1); ss += __shfl_xor(ss, 2); ss += __shfl_xor(ss, 4); ss += __shfl_xor(ss, 8);
                float rs = rsqrtf(ss * (1.f / 64.f) + EPS);
                u32x2 w; w.x = pk2(o[0] * rs * ng[0] * silu_f(g[0]), o[1] * rs * ng[1] * silu_f(g[1])); w.y = pk2(o[2] * rs * ng[2] * silu_f(g[2]), o[3] * rs * ng[3] * silu_f(g[3]));
                *(u32x2*)(MIX + kb_off(rr, 640 + lane * 4, NROWS)) = w;
                unpack4(of1[r], a); unpack4(ob1[r], b); unpack4(gt1[r], g);
                ss = 0.f;
#pragma unroll
                for (int e = 0; e < 4; ++e) { o[e] = a[e] + b[e]; ss += o[e] * o[e]; }
                ss += __shfl_xor(ss, 1); ss += __shfl_xor(ss, 2); ss += __shfl_xor(ss, 4); ss += __shfl_xor(ss, 8);
                rs = rsqrtf(ss * (1.f / 64.f) + EPS);
                w.x = pk2(o[0] * rs * ng[0] * silu_f(g[0]), o[1] * rs * ng[1] * silu_f(g[1])); w.y = pk2(o[2] * rs * ng[2] * silu_f(g[2]), o[3] * rs * ng[3] * silu_f(g[3]));
                if (lane < 32) *(u32x2*)(MIX + kb_off(rr, 896 + lane * 4, NROWS)) = w; }
        }
    }
}

template <class F>
__device__ __forceinline__ void conv8_slide(const bf16_t* src, int ld, int row_of_t0  , int row_stride, int tstart, int N,
                                            const float* w, int wld, const float* bias, F&& emit) {
    float wt[5][8], bs[8];
#pragma unroll
    for (int k = 0; k < 5; ++k) { const f32x4 a = *(const f32x4*)(w + (size_t)k * wld), b = *(const f32x4*)(w + (size_t)k * wld + 4);
        wt[k][0] = a[0]; wt[k][1] = a[1]; wt[k][2] = a[2]; wt[k][3] = a[3]; wt[k][4] = b[0]; wt[k][5] = b[1]; wt[k][6] = b[2]; wt[k][7] = b[3]; }
    if (bias) { const f32x4 a = *(const f32x4*)bias, b = *(const f32x4*)(bias + 4); bs[0] = a[0]; bs[1] = a[1]; bs[2] = a[2]; bs[3] = a[3]; bs[4] = b[0]; bs[5] = b[1]; bs[6] = b[2]; bs[7] = b[3]; }
    else {
#pragma unroll
        for (int e = 0; e < 8; ++e) bs[e] = 0.f; }
    u32x4 win[12];
#pragma unroll
    for (int i = 0; i < 12; ++i) { const int t = tstart - 2 + i;
        win[i] = (t >= 0 && t < N) ? *(const u32x4*)(src + (size_t)(row_of_t0 + (i - 2) * row_stride) * ld) : (u32x4){0u, 0u, 0u, 0u}; }
#pragma unroll
    for (int i = 0; i < 8; ++i) {
        float o[8];
#pragma unroll
        for (int e = 0; e < 8; ++e) o[e] = bs[e];
#pragma unroll
        for (int k = 0; k < 5; ++k) { float f[8]; unpack8(win[i + k], f);
#pragma unroll
            for (int e = 0; e < 8; ++e) o[e] += wt[k][e] * f[e]; }
#pragma unroll
        for (int e = 0; e < 8; ++e) o[e] = silu_f(o[e]);
        emit(i, o);
    }
}

__device__ __forceinline__ float wave_scan_dir(float v, int lane, int dir) {
    float x = v;
    if (dir == 0) {
#pragma unroll
        for (int o = 1; o < 64; o <<= 1) { const float y = __shfl_up(x, o); if (lane >= o) x += y; }
    } else {
#pragma unroll
        for (int o = 1; o < 64; o <<= 1) { const float y = __shfl_down(x, o); if (lane + o < 64) x += y; }
    }
    return x;
}

__device__ __forceinline__ void ssd_chunk_geom(int cid, int& t0, int& N) {
    if (cid < 512) { t0 = (cid & 255) * 64; N = T; } else { t0 = ((cid - 512) & 3) * 64; N = TC; }
}

constexpr int LDT = 72;
__device__ __forceinline__ void ssd_passA_unit(const Params& p, int l, int cid, int g, LAS unsigned char* lds) {
    lds = opaque_lds(lds);
    const int tid = opaque_tid(), lane = tid & 63, wv = __builtin_amdgcn_readfirstlane(tid >> 6), fr = lane & 15, fq = lane >> 4;
    const bf16_t* P1 = (const bf16_t*)(p.ws + WS_RB);
    bf16_t* SS = (bf16_t*)(p.ws + WS_RA);
    float* SSDCD = (float*)(p.ws + WS_SSDCD);
    LAS bf16_t* XT = (LAS bf16_t*)lds;
    LAS bf16_t* BT = XT + 3 * 64 * LDT;
    LAS float* WGT = (LAS float*)(BT + 128 * LDT);
    int t0, N; ssd_chunk_geom(cid, t0, N);
    const int row0 = cid * 64;
    for (int s = wv; s < 6; s += 4) {
        const int hl = s >> 1, dir = s & 1, h = g * 3 + hl;
        const float dtr = bf2f(P1[(size_t)(row0 + lane) * P1_LD + C_DT + dir * 6 + h]);
        const float dt = softplus_f(dtr + p.ssd_dt_bias[(l * 2 + dir) * 6 + h]);
        const float a = -__expf(p.ssd_a_log[(l * 2 + dir) * 6 + h]);
        const float ac = wave_scan_dir(dt * a, lane, dir);
        const float aend = __shfl(ac, dir ? 0 : 63);
        WGT[s * 64 + lane] = __expf(aend - ac) * dt;
        if (lane == 0) SSDCD[((size_t)dir * NCHUNK + cid) * 6 + h] = __expf(aend);
    }
    for (int pass = 0; pass < 2; ++pass) {
        const int vs = pass * 32 + (tid & 31), tg = tid >> 5;
        if (vs < 40) {
            const int isB = vs >= 24;
            const int ch = isB ? (384 + g * 128 + (vs - 24) * 8) : (g * 192 + vs * 8);
            const int ts = t0 + tg * 8;
            conv8_slide(P1 + C_XS + ch, P1_LD, row0 + tg * 8, 1, ts, N, p.ssd_conv_w + (size_t)l * 5 * 896 + ch, 896, p.ssd_conv_b + l * 896 + ch,
                [&](int i, const float (&o)[8]) {
                    const int j = tg * 8 + i;
                    if (isB) { const int n0 = (vs - 24) * 8;
#pragma unroll
                        for (int e = 0; e < 8; ++e) BT[(n0 + e) * LDT + j] = f2bf(o[e]); }
                    else { const int hl = vs >> 3, p0 = (vs & 7) * 8;
#pragma unroll
                        for (int e = 0; e < 8; ++e) XT[(hl * 64 + p0 + e) * LDT + j] = f2bf(o[e]); }
                });
        }
    }
    __syncthreads();
    for (int s = 0; s < 6; ++s) {
        const int hl = s >> 1, dir = s & 1, h = g * 3 + hl;
        bf16x8 bfr[2];
#pragma unroll
        for (int ks = 0; ks < 2; ++ks) {
            const u32x4 raw = *(const LAS u32x4*)(XT + (hl * 64 + wv * 16 + fr) * LDT + ks * 32 + fq * 8);
            float f[8]; unpack8(raw, f);
            const LAS float* wp = WGT + s * 64 + ks * 32 + fq * 8;
            u32x4 o; o.x = pk2(f[0] * wp[0], f[1] * wp[1]); o.y = pk2(f[2] * wp[2], f[3] * wp[3]); o.z = pk2(f[4] * wp[4], f[5] * wp[5]); o.w = pk2(f[6] * wp[6], f[7] * wp[7]);
            bfr[ks] = __builtin_bit_cast(bf16x8, o);
        }
        bf16_t* dst = SS + (((size_t)dir * NCHUNK + cid) * 6 + h) * 8192;
#pragma unroll
        for (int mt = 0; mt < 8; ++mt) {
            f32x4 acc = (f32x4){0.f, 0.f, 0.f, 0.f};
#pragma unroll
            for (int ks = 0; ks < 2; ++ks) acc = MFMA16(ldfrag(BT, LDT, mt * 16, ks * 32, lane), bfr[ks], acc);
            u32x2 w; w.x = pk2(acc[0], acc[1]); w.y = pk2(acc[2], acc[3]);
            *(u32x2*)(dst + (size_t)(wv * 16 + fr) * 128 + mt * 16 + 4 * fq) = w;
        }
    }
    __syncthreads();
}

__device__ __forceinline__ void tri_solve_blk(const LAS float* X, LAS bf16_t* Tm, int lane) {
    const int fr = lane & 15, fq = lane >> 4;
#pragma unroll
    for (int c = 0; c < 9; ++c) *(LAS u32x4*)(Tm + (c * 64 + lane) * 8) = (u32x4){0u, 0u, 0u, 0u};
    asm volatile("s_waitcnt lgkmcnt(0)" ::: "memory");
    {
        const LAS float* Xb = X + (16 * fq) * 64 + 16 * fq;
        float t[16];
#pragma unroll
        for (int r = 0; r < 16; ++r) {
            float acc = (r == fr) ? 1.f : 0.f;
#pragma unroll
            for (int k = 0; k < r; ++k) acc -= Xb[r * 64 + k] * t[k];
            t[r] = acc;
        }
#pragma unroll
        for (int r = 0; r < 16; ++r) Tm[(16 * fq + r) * LDT + 16 * fq + fr] = f2bf(t[r]);
    }
    asm volatile("s_waitcnt lgkmcnt(0)" ::: "memory");
#pragma unroll
    for (int pr = 0; pr < 2; ++pr) {
        const int a = 2 * pr, b = 2 * pr + 1;
        f32x4 x0 = (f32x4){0.f, 0.f, 0.f, 0.f}, x1 = x0; u32x4 tb = (u32x4){0u, 0u, 0u, 0u};
        if (fq < 2) {
            x0 = *(const LAS f32x4*)(X + (16 * b + fr) * 64 + 16 * a + 8 * fq); x1 = *(const LAS f32x4*)(X + (16 * b + fr) * 64 + 16 * a + 8 * fq + 4);
            unsigned tv[8];
#pragma unroll
            for (int e = 0; e < 8; ++e) tv[e] = Tm[(16 * a + 8 * fq + e) * LDT + 16 * a + fr];
            tb.x = tv[0] | (tv[1] << 16); tb.y = tv[2] | (tv[3] << 16); tb.z = tv[4] | (tv[5] << 16); tb.w = tv[6] | (tv[7] << 16);
        }
        u32x4 xa; xa.x = pk2(x0[0], x0[1]); xa.y = pk2(x0[2], x0[3]); xa.z = pk2(x1[0], x1[1]); xa.w = pk2(x1[2], x1[3]);
        const f32x4 m1 = MFMA16(__builtin_bit_cast(bf16x8, xa), __builtin_bit_cast(bf16x8, tb), ((f32x4){0.f, 0.f, 0.f, 0.f}));
        u32x4 bo; bo.x = pk2(m1[0], m1[1]); bo.y = pk2(m1[2], m1[3]); bo.z = 0u; bo.w = 0u;
        const u32x2 ta = *(const LAS u32x2*)(Tm + (16 * b + fr) * LDT + 16 * b + 4 * fq);
        u32x4 ao; ao.x = ta.x; ao.y = ta.y; ao.z = 0u; ao.w = 0u;
        const f32x4 t10 = MFMA16(__builtin_bit_cast(bf16x8, ao), __builtin_bit_cast(bf16x8, bo), ((f32x4){0.f, 0.f, 0.f, 0.f}));
#pragma unroll
        for (int r = 0; r < 4; ++r) Tm[(16 * b + 4 * fq + r) * LDT + 16 * a + fr] = f2bf(-t10[r]);
    }
    asm volatile("s_waitcnt lgkmcnt(0)" ::: "memory");
    {
        bf16x8 xa2[2], tb2[2];
#pragma unroll
        for (int mt = 0; mt < 2; ++mt) { const f32x4 x0 = *(const LAS f32x4*)(X + (32 + 16 * mt + fr) * 64 + 8 * fq), x1 = *(const LAS f32x4*)(X + (32 + 16 * mt + fr) * 64 + 8 * fq + 4);
            u32x4 o; o.x = pk2(x0[0], x0[1]); o.y = pk2(x0[2], x0[3]); o.z = pk2(x1[0], x1[1]); o.w = pk2(x1[2], x1[3]); xa2[mt] = __builtin_bit_cast(bf16x8, o); }
#pragma unroll
        for (int nt = 0; nt < 2; ++nt) { unsigned tv[8];
#pragma unroll
            for (int e = 0; e < 8; ++e) tv[e] = Tm[(8 * fq + e) * LDT + 16 * nt + fr];
            u32x4 o; o.x = tv[0] | (tv[1] << 16); o.y = tv[2] | (tv[3] << 16); o.z = tv[4] | (tv[5] << 16); o.w = tv[6] | (tv[7] << 16); tb2[nt] = __builtin_bit_cast(bf16x8, o); }
        f32x4 m2[2][2];
#pragma unroll
        for (int mt = 0; mt < 2; ++mt)
#pragma unroll
            for (int nt = 0; nt < 2; ++nt) m2[mt][nt] = MFMA16(xa2[mt], tb2[nt], ((f32x4){0.f, 0.f, 0.f, 0.f}));
        bf16x8 bo[2], ao[2];
#pragma unroll
        for (int nt = 0; nt < 2; ++nt) { u32x4 o; o.x = pk2(m2[0][nt][0], m2[0][nt][1]); o.y = pk2(m2[0][nt][2], m2[0][nt][3]); o.z = pk2(m2[1][nt][0], m2[1][nt][1]); o.w = pk2(m2[1][nt][2], m2[1][nt][3]);
            bo[nt] = __builtin_bit_cast(bf16x8, o); }
#pragma unroll
        for (int mt = 0; mt < 2; ++mt) { const u32x2 lo = *(const LAS u32x2*)(Tm + (32 + 16 * mt + fr) * LDT + 32 + 4 * fq), hi = *(const LAS u32x2*)(Tm + (32 + 16 * mt + fr) * LDT + 48 + 4 * fq);
            u32x4 o; o.x = lo.x; o.y = lo.y; o.z = hi.x; o.w = hi.y; ao[mt] = __builtin_bit_cast(bf16x8, o); }
#pragma unroll
        for (int mt = 0; mt < 2; ++mt)
#pragma unroll
            for (int nt = 0; nt < 2; ++nt) { const f32x4 r2 = MFMA16(ao[mt], bo[nt], ((f32x4){0.f, 0.f, 0.f, 0.f}));
#pragma unroll
                for (int r = 0; r < 4; ++r) Tm[(32 + 16 * mt + 4 * fq + r) * LDT + 16 * nt + fr] = f2bf(-r2[r]); }
    }
    asm volatile("s_waitcnt lgkmcnt(0)" ::: "memory");
}

__device__ __forceinline__ int kperm(int c) { const int w = c & 31; return (c & 32) + 8 * ((w & 15) >> 2) + (w & 3) + 4 * (w >> 4); }

struct PrepIn { u32x4 win[12]; float ar[2], br[2]; };
__device__ __forceinline__ void gdn_prep_load(const Params& p, int cid, int h, int lane, int wv, PrepIn& in) {
    const bf16_t* P1 = (const bf16_t*)(p.ws + WS_RB);
    const bf16_t* P2 = (const bf16_t*)((unsigned char*)p.out);
    int set, p0, N;
    if (cid < 512) { set = cid >> 8; p0 = (cid & 255) * 64; N = T; } else { set = 2 + ((cid - 512) >> 2); p0 = ((cid - 512) & 3) * 64; N = TC; }
    if (wv < 3) {
        const int tg = lane >> 3, vsl = lane & 7, ch = wv * 384 + h * 64 + vsl * 8;
        const int ps = p0 + tg * 8;
#pragma unroll
        for (int i = 0; i < 12; ++i) { const int pp = ps - 2 + i;
            in.win[i] = (pp >= 0 && pp < N) ? *(const u32x4*)(P2 + (size_t)gdn_pos_row(set, pp) * P2_LD + ch) : (u32x4){0u, 0u, 0u, 0u}; }
    } else {
        const size_t row = (size_t)gdn_pos_row(set, p0 + lane);
#pragma unroll
        for (int dir = 0; dir < 2; ++dir) { in.ar[dir] = bf2f(P1[row * P1_LD + C_AR + dir * 6 + h]); in.br[dir] = bf2f(P1[row * P1_LD + C_BR + dir * 6 + h]); }
    }
}
__device__ __forceinline__ void gdn_prep_unit(const Params& p, int l, int cid, int h, LAS unsigned char* lds, PrepIn& in, int ncid, int nh, bool has_next) {
    lds = opaque_lds(lds);
    const int tid = opaque_tid(), lane = tid & 63, wv = __builtin_amdgcn_readfirstlane(tid >> 6), fr = lane & 15, fq = lane >> 4;
    const bf16_t* P1 = (const bf16_t*)(p.ws + WS_RB);
    const bf16_t* P2 = (const bf16_t*)((unsigned char*)p.out);
    bf16_t* OUT = (bf16_t*)(p.ws + WS_RD + (size_t)(cid * 6 + h) * GPREP_BYTES);
    float* AUX = (float*)(p.ws + WS_GAUX) + (size_t)(cid * 6 + h) * GAUX_N;
    LAS bf16_t* Qs = (LAS bf16_t*)lds;
    LAS bf16_t* Ks = Qs + 64 * LDT;
    LAS bf16_t* KT = Ks + 64 * LDT;
    LAS bf16_t* VT = KT + 64 * LDT;
    LAS bf16_t* Tf = VT + 64 * LDT;
    LAS bf16_t* Tb = Tf + 64 * LDT;
    LAS float* XB = (LAS float*)(Tb + 64 * LDT);
    LAS float* XA = (LAS float*)lds;
    LAS float* SER = XB + 4096;
    int set, p0, N;
    if (cid < 512) { set = cid >> 8; p0 = (cid & 255) * 64; N = T; } else { set = 2 + ((cid - 512) >> 2); p0 = ((cid - 512) & 3) * 64; N = TC; }
    if (wv < 3) {
        const int tg = lane >> 3, vsl = lane & 7, ch = wv * 384 + h * 64 + vsl * 8;
        const int ps = p0 + tg * 8;
        float wt[5][8];
#pragma unroll
        for (int k = 0; k < 5; ++k) { const float* w = p.gdn_conv_w + ((size_t)l * 5 + k) * 1152 + ch; const f32x4 a = *(const f32x4*)w, b = *(const f32x4*)(w + 4);
            wt[k][0] = a[0]; wt[k][1] = a[1]; wt[k][2] = a[2]; wt[k][3] = a[3]; wt[k][4] = b[0]; wt[k][5] = b[1]; wt[k][6] = b[2]; wt[k][7] = b[3]; }
        float o[8][8];
#pragma unroll
        for (int i = 0; i < 8; ++i)
#pragma unroll
            for (int e = 0; e < 8; ++e) o[i][e] = 0.f;
#pragma unroll
        for (int w = 0; w < 12; ++w) { float f[8]; unpack8(in.win[w], f);
#pragma unroll
            for (int k = 0; k < 5; ++k) { const int i = w - k;
                if (i >= 0 && i < 8) {
#pragma unroll
                    for (int e = 0; e < 8; ++e) o[i][e] += wt[k][e] * f[e]; } } }
#pragma unroll
        for (int i = 0; i < 8; ++i) {
            float ss = 0.f;
#pragma unroll
            for (int e = 0; e < 8; ++e) { o[i][e] = silu_f(o[i][e]); ss += o[i][e] * o[i][e]; }
            if (wv < 2) {
                ss += __shfl_xor(ss, 1); ss += __shfl_xor(ss, 2); ss += __shfl_xor(ss, 4);
                const float sc = rsqrtf(ss + EPS) * (wv == 0 ? 0.125f : 1.f);
#pragma unroll
                for (int e = 0; e < 8; ++e) o[i][e] *= sc;
                u32x4 w; w.x = pk2(o[i][0], o[i][1]); w.y = pk2(o[i][2], o[i][3]); w.z = pk2(o[i][4], o[i][5]); w.w = pk2(o[i][6], o[i][7]);
                *(LAS u32x4*)((wv == 0 ? Qs : Ks) + (tg * 8 + i) * LDT + vsl * 8) = w;
            }
        }
        if (wv >= 1) {
            LAS bf16_t* TT = (wv == 1) ? KT : VT;
#pragma unroll
            for (int e = 0; e < 8; ++e) {
                u32x4 w; w.x = pk2(o[0][e], o[1][e]); w.y = pk2(o[2][e], o[3][e]); w.z = pk2(o[4][e], o[5][e]); w.w = pk2(o[6][e], o[7][e]);
                *(LAS u32x4*)(TT + (vsl * 8 + e) * LDT + tg * 8) = w; }
        }
    } else {
        const size_t row = (size_t)gdn_pos_row(set, p0 + lane);
        float gc[2], beta[2];
#pragma unroll
        for (int dir = 0; dir < 2; ++dir) {
            const float ar = in.ar[dir], br = in.br[dir];
            const float gg = -__expf(p.gdn_a_log[(l * 2 + dir) * 6 + h]) * softplus_f(ar + p.gdn_dt_bias[(l * 2 + dir) * 6 + h]);
            gc[dir] = wave_scan_dir(gg, lane, dir); beta[dir] = sigmoid_f(br);
        }
        const float gendf = __shfl(gc[0], 63), gendb = __shfl(gc[1], 0);
        SER[lane] = gc[0]; SER[64 + lane] = gc[1]; SER[128 + lane] = beta[0]; SER[192 + lane] = beta[1];
        SER[256 + lane] = -beta[0] * __expf(gc[0]); SER[320 + lane] = -beta[1] * __expf(gc[1]);
        AUX[lane] = __expf(gc[0]); AUX[64 + lane] = __expf(gc[1]); AUX[128 + lane] = __expf(gendf - gc[0]); AUX[192 + lane] = __expf(gendb - gc[1]);
        if (lane == 0) { AUX[256] = __expf(gendf); AUX[257] = __expf(gendb); }
    }
    __syncthreads();
    if (has_next) gdn_prep_load(p, ncid, nh, lane, wv, in);
    for (int c = tid; c < 1024; c += NTHR) { const int r = c >> 4, cc = (c & 15) * 4;
        *(u32x2*)(OUT + 5 * 4096 + r * 64 + kperm(cc)) = *(const LAS u32x2*)(Qs + r * LDT + cc);
        *(u32x2*)(OUT + 6 * 4096 + r * 64 + kperm(cc)) = *(const LAS u32x2*)(KT + r * LDT + cc); }
    {
        f32x4 kk[4], qk[4];
#pragma unroll
        for (int nt = 0; nt < 4; ++nt) { kk[nt] = (f32x4){0.f, 0.f, 0.f, 0.f}; qk[nt] = (f32x4){0.f, 0.f, 0.f, 0.f}; }
#pragma unroll
        for (int ks = 0; ks < 2; ++ks) {
            const bf16x8 kb = ldfrag(Ks, LDT, wv * 16, ks * 32, lane), qb = ldfrag(Qs, LDT, wv * 16, ks * 32, lane);
#pragma unroll
            for (int nt = 0; nt < 4; ++nt) { const bf16x8 ka = ldfrag(Ks, LDT, nt * 16, ks * 32, lane); kk[nt] = MFMA16(ka, kb, kk[nt]); qk[nt] = MFMA16(ka, qb, qk[nt]); }
        }
        __syncthreads();
        const int i = wv * 16 + fr;
        const float gcf_i = SER[i], gcb_i = SER[64 + i], bf_i = SER[128 + i], bb_i = SER[192 + i];
#pragma unroll
        for (int nt = 0; nt < 4; ++nt) {
            f32x4 xo; float at[4];
#pragma unroll
            for (int r = 0; r < 4; ++r) { const int j = nt * 16 + 4 * fq + r;
                float dec; xo[r] = 0.f;
                if (j < i) { dec = __expf(gcf_i - SER[j]); xo[r] = bf_i * kk[nt][r] * dec; }
                else if (j > i) { dec = __expf(gcb_i - SER[64 + j]); XB[(63 - i) * 64 + (63 - j)] = bb_i * kk[nt][r] * dec; }
                else dec = 1.f;
                at[r] = qk[nt][r] * dec; }
            *(LAS f32x4*)(XA + i * 64 + nt * 16 + 4 * fq) = xo;
            u32x2 w; w.x = pk2(at[0], at[1]); w.y = pk2(at[2], at[3]);
            *(u32x2*)(OUT + 4 * 4096 + i * 64 + kperm(nt * 16 + 4 * fq)) = w;
        }
    }
    __syncthreads();
    if (wv == 0) tri_solve_blk(XA, Tf, lane);
    else if (wv == 1) tri_solve_blk(XB, Tb, lane);
    __syncthreads();
    {
        const int dir = wv & 1, which = wv >> 1;
        const LAS bf16_t* Tm = dir ? Tb : Tf;
        const LAS bf16_t* Src = which ? KT : VT;
        const LAS float* scl = SER + (which ? 256 : 128) + dir * 64;
        bf16x8 tfr[4][2];
#pragma unroll
        for (int lt = 0; lt < 4; ++lt)
#pragma unroll
            for (int ks = 0; ks < 2; ++ks) tfr[lt][ks] = ldfrag(Tm, LDT, lt * 16, ks * 32, lane);
        bf16_t* dst = OUT + (which ? 0 : 2 * 4096) + dir * 4096;
#pragma unroll
        for (int vt = 0; vt < 4; ++vt) {
            bf16x8 sfr[2];
#pragma unroll
            for (int ks = 0; ks < 2; ++ks) {
                const int j0 = dir ? (56 - ks * 32 - fq * 8) : (ks * 32 + fq * 8);
                const u32x4 raw = *(const LAS u32x4*)(Src + (vt * 16 + fr) * LDT + j0);
                float f[8]; unpack8(raw, f);
                const LAS float* sp = scl + j0;
#pragma unroll
                for (int e = 0; e < 8; ++e) f[e] *= sp[e];
                u32x4 o;
                if (dir) { o.x = pk2(f[7], f[6]); o.y = pk2(f[5], f[4]); o.z = pk2(f[3], f[2]); o.w = pk2(f[1], f[0]); }
                else { o.x = pk2(f[0], f[1]); o.y = pk2(f[2], f[3]); o.z = pk2(f[4], f[5]); o.w = pk2(f[6], f[7]); }
                sfr[ks] = __builtin_bit_cast(bf16x8, o);
            }
#pragma unroll
            for (int lt = 0; lt < 4; ++lt) {
                f32x4 acc = (f32x4){0.f, 0.f, 0.f, 0.f};
#pragma unroll
                for (int ks = 0; ks < 2; ++ks) acc = which ? MFMA16(sfr[ks], tfr[lt][ks], acc) : MFMA16(tfr[lt][ks], sfr[ks], acc);
                if (which) { u32x2 w; w.x = pk2(acc[0], acc[1]); w.y = pk2(acc[2], acc[3]);
                    const int lrow = dir ? 63 - (lt * 16 + fr) : lt * 16 + fr;
                    *(u32x2*)(dst + lrow * 64 + kperm(vt * 16 + 4 * fq)) = w; }
                else if (dir) { u32x2 w; w.x = pk2(acc[3], acc[2]); w.y = pk2(acc[1], acc[0]);
                    *(u32x2*)(dst + (vt * 16 + fr) * 64 + 60 - (lt * 16 + 4 * fq)) = w; }
                else { u32x2 w; w.x = pk2(acc[0], acc[1]); w.y = pk2(acc[2], acc[3]);
                    *(u32x2*)(dst + (vt * 16 + fr) * 64 + lt * 16 + 4 * fq) = w; }
            }
        }
    }
    __syncthreads();
}

constexpr int SP_GDN_UNITS = NCHUNK * 6, SP_SSD_UNITS = NCHUNK * 2;
__device__ __forceinline__ void phase_gdn_prep(const Params& p, int l, LAS unsigned char* lds) {
    const int lane = LTID & 63, wv = __builtin_amdgcn_readfirstlane(LTID >> 6);
    const int niter = PADDED_ITERS(SP_GDN_UNITS);
    PrepIn in;
#pragma unroll
    for (int i = 0; i < 12; ++i) in.win[i] = (u32x4){0u, 0u, 0u, 0u};
    in.ar[0] = in.ar[1] = in.br[0] = in.br[1] = 0.f;
    int u = VB < SP_GDN_UNITS ? VB : SP_GDN_UNITS - 1;
    gdn_prep_load(p, u / 6, u % 6, lane, wv, in);
    for (int it = 0; it < niter; ++it) {
        int un = VB + (it + 1) * NVB; if (un >= SP_GDN_UNITS) un = SP_GDN_UNITS - 1;
        gdn_prep_unit(p, l, u / 6, u % 6, lds, in, un / 6, un % 6, it + 1 < niter);
        u = un;
    }
}

__device__ __forceinline__ int chain_cid(int b, int dir, int q) {
    if (q < 4) return 512 + b * 4 + (dir ? 3 - q : q);
    const int c = q - 4; return b * 256 + (dir ? 255 - c : c);
}
__device__ __forceinline__ unsigned mask_pair(unsigned w, bool keep_lo, bool keep_hi) { return (keep_lo ? (w & 0xffffu) : 0u) | (keep_hi ? (w & 0xffff0000u) : 0u); }

__device__ __forceinline__ unsigned pk2s(float lo, float hi) { return pk2(lo, hi); }
__device__ __forceinline__ void chain_compute(f32x4 (&S)[4], u32x4& sp0, u32x4& sp1, const LAS bf16_t* NWs, const LAS bf16_t* ATs, const LAS bf16_t* Qs, const LAS bf16_t* KTs, const LAS float* AX,
                                              const LAS bf16_t* Us, bf16_t* O, int cid, int h, int dir, bool last, int lane, int wv, int fr, int fq, const u32x4 (&amask)[2]) {
    const int sw = fr >> 1;
#define CH_FRAG(T, mt, ks) (*(const LAS bf16x8*)((T) + ((mt) * 16 + fr) * 64 + (((4 * (ks) + fq) ^ sw) * 8)))
    bf16x8 nwf[4][2], qf[4][2]; float eg[4]; u32x2 uw[4];
#pragma unroll
    for (int mt = 0; mt < 4; ++mt) uw[mt] = *(const LAS u32x2*)(Us + (wv * 16 + fr) * 64 + (((2 * mt + (fq >> 1)) ^ sw) * 8) + (fq & 1) * 4);
#pragma unroll
    for (int mt = 0; mt < 4; ++mt) {
        nwf[mt][0] = CH_FRAG(NWs, mt, 0); nwf[mt][1] = CH_FRAG(NWs, mt, 1);
        qf[mt][0] = CH_FRAG(Qs, mt, 0); qf[mt][1] = CH_FRAG(Qs, mt, 1);
        eg[mt] = AX[mt * 16 + fr];
    }
    const float gend = AX[128];
    const bf16x8 sb0 = __builtin_bit_cast(bf16x8, sp0), sb1 = __builtin_bit_cast(bf16x8, sp1);
    f32x4 vn[4], oo[4];
#pragma unroll
    for (int mt = 0; mt < 4; ++mt) {
        f32x4 a = (f32x4){__uint_as_float(uw[mt].x << 16), __uint_as_float(uw[mt].x & 0xffff0000u), __uint_as_float(uw[mt].y << 16), __uint_as_float(uw[mt].y & 0xffff0000u)};
        a = MFMA16(nwf[mt][0], sb0, a);
        a = MFMA16(nwf[mt][1], sb1, a);
        vn[mt] = a;
    }
    bf16x8 ktf[4][2]; u32x4 atw[4][2]; f32x4 ep[4];
#pragma unroll
    for (int mt = 0; mt < 4; ++mt) {
        ktf[mt][0] = CH_FRAG(KTs, mt, 0); ktf[mt][1] = CH_FRAG(KTs, mt, 1);
        atw[mt][0] = __builtin_bit_cast(u32x4, CH_FRAG(ATs, mt, 0)); atw[mt][1] = __builtin_bit_cast(u32x4, CH_FRAG(ATs, mt, 1));
        ep[mt] = *(const LAS f32x4*)(AX + 64 + mt * 16 + 4 * fq);
    }
#pragma unroll
    for (int mt = 0; mt < 4; ++mt) {
        f32x4 o = (f32x4){0.f, 0.f, 0.f, 0.f};
        o = MFMA16(sb0, qf[mt][0], o);
        o = MFMA16(sb1, qf[mt][1], o);
        f32x2 eg2 = (f32x2){eg[mt], eg[mt]}; asm volatile("" : "+v"(eg2));
        const f32x2 o01 = (f32x2){o[0], o[1]} * eg2, o23 = (f32x2){o[2], o[3]} * eg2;
        oo[mt] = (f32x4){o01[0], o01[1], o23[0], o23[1]};
    }
    u32x4 vp0, vp1, vq0, vq1;
    vp0.x = pk2(vn[0][0], vn[0][1]); vp0.y = pk2(vn[0][2], vn[0][3]); vp0.z = pk2(vn[1][0], vn[1][1]); vp0.w = pk2(vn[1][2], vn[1][3]);
    vp1.x = pk2(vn[2][0], vn[2][1]); vp1.y = pk2(vn[2][2], vn[2][3]); vp1.z = pk2(vn[3][0], vn[3][1]); vp1.w = pk2(vn[3][2], vn[3][3]);
    vq0.x = pk2(vn[0][0] * ep[0][0], vn[0][1] * ep[0][1]); vq0.y = pk2(vn[0][2] * ep[0][2], vn[0][3] * ep[0][3]); vq0.z = pk2(vn[1][0] * ep[1][0], vn[1][1] * ep[1][1]); vq0.w = pk2(vn[1][2] * ep[1][2], vn[1][3] * ep[1][3]);
    vq1.x = pk2(vn[2][0] * ep[2][0], vn[2][1] * ep[2][1]); vq1.y = pk2(vn[2][2] * ep[2][2], vn[2][3] * ep[2][3]); vq1.z = pk2(vn[3][0] * ep[3][0], vn[3][1] * ep[3][1]); vq1.w = pk2(vn[3][2] * ep[3][2], vn[3][3] * ep[3][3]);
    const bf16x8 vb0 = __builtin_bit_cast(bf16x8, vp0), vb1 = __builtin_bit_cast(bf16x8, vp1), vc0 = __builtin_bit_cast(bf16x8, vq0), vc1 = __builtin_bit_cast(bf16x8, vq1);
    f32x2 gend2 = (f32x2){gend, gend}; asm volatile("" : "+v"(gend2));
#pragma unroll
    for (int mt = 0; mt < 4; ++mt) {
        f32x4 sn;
#pragma unroll
        for (int r = 0; r < 4; r += 2) { const f32x2 t2 = (f32x2){S[mt][r], S[mt][r + 1]} * gend2; sn[r] = t2[0]; sn[r + 1] = t2[1]; }
        sn = MFMA16(ktf[mt][0], vc0, sn);
        sn = MFMA16(ktf[mt][1], vc1, sn);
        S[mt] = sn;
    }
    sp0.x = pk2(S[0][0], S[0][1]); sp0.y = pk2(S[0][2], S[0][3]); sp0.z = pk2(S[1][0], S[1][1]); sp0.w = pk2(S[1][2], S[1][3]);
    sp1.x = pk2(S[2][0], S[2][1]); sp1.y = pk2(S[2][2], S[2][3]); sp1.z = pk2(S[3][0], S[3][1]); sp1.w = pk2(S[3][2], S[3][3]);
#pragma unroll
    for (int mt = 0; mt < 4; ++mt) {
        const int kd = mt >> 1;
        u32x4 aw = atw[mt][kd];
        aw.x &= amask[mt & 1].x; aw.y &= amask[mt & 1].y; aw.z &= amask[mt & 1].z; aw.w &= amask[mt & 1].w;
        oo[mt] = MFMA16(kd ? vb1 : vb0, __builtin_bit_cast(bf16x8, aw), oo[mt]);
        const bool other = dir ? (mt < 2) : (mt >= 2);
        if (other) oo[mt] = MFMA16(kd ? vb0 : vb1, __builtin_bit_cast(bf16x8, atw[mt][kd ^ 1]), oo[mt]);
    }
    if (!(last && cid >= 512)) {
        bf16_t* ob = O + (size_t)(cid * 6 + h) * 4096 + fr * 64 + wv * 16 + 4 * fq;
#pragma unroll
        for (int mt = 0; mt < 4; ++mt) { u32x2 w; w.x = pk2(oo[mt][0], oo[mt][1]); w.y = pk2(oo[mt][2], oo[mt][3]); *(u32x2*)(ob + mt * 1024) = w; }
    }
}
#undef CH_FRAG

__device__ __forceinline__ void gdn_chain(const Params& p, int l, int chain, LAS unsigned char* lds, bool loader) {
    lds = opaque_lds(lds);
    const int tid = opaque_tid(), lane = tid & 63, wv = __builtin_amdgcn_readfirstlane(tid >> 6), fr = lane & 15, fq = lane >> 4;
    const int b = chain / 12, h = (chain % 12) >> 1, dir = chain & 1;
    const bool last = (l == NL - 1);
    bf16_t* O = (bf16_t*)((unsigned char*)p.out) + (size_t)dir * NCHUNK * 6 * 4096;
    constexpr int TSET = 5 * 4096;
    LAS bf16_t* TB = (LAS bf16_t*)lds;
    LAS float* AXB = (LAS float*)(TB + 3 * TSET);
    f32x4 S[4];
#pragma unroll
    for (int mt = 0; mt < 4; ++mt) S[mt] = (f32x4){0.f, 0.f, 0.f, 0.f};
    u32x4 amask[2];
#pragma unroll
    for (int par = 0; par < 2; ++par) { unsigned w[4];
#pragma unroll
        for (int j = 0; j < 4; ++j) { bool k[2];
#pragma unroll
            for (int x = 0; x < 2; ++x) { const int e = 2 * j + x; const int lp = (e < 4) ? (4 * fq + e) : (16 + 4 * fq + e - 4);
                const int dd = 16 * par + fr - lp;
                k[x] = dir ? (dd <= 0) : (dd >= 0); }
            w[j] = (k[0] ? 0xffffu : 0u) | (k[1] ? 0xffff0000u : 0u); }
        amask[par] = (u32x4){w[0], w[1], w[2], w[3]}; }
    if (loader) {
        const int i = tid & 63;
        unsigned soff[2], doff[2];
#pragma unroll
        for (int j = 0; j < 2; ++j) { const int pc = 2 * wv + j, r = pc * 8 + (i >> 3), pch = i & 7;
            soff[j] = (unsigned)(r * 128 + ((pch ^ ((r >> 1) & 7)) * 16)); doff[j] = (unsigned)(pc * 1024 + i * 16); }
        const int auxi = tid < 64 ? dir * 64 + tid : (tid < 128 ? 128 + dir * 64 + (tid - 64) : 256 + dir);
#define CH_DMA(q, set) do { \
        const int cid_ = chain_cid(b, dir, (q)); \
        const char* sb_ = (const char*)(p.ws + WS_RD + (size_t)(cid_ * 6 + h) * GPREP_BYTES); \
        LAS unsigned char* db_ = (LAS unsigned char*)(TB + (set) * TSET); \
        _Pragma("unroll") for (int t5 = 0; t5 < 5; ++t5) { const int gk = t5 == 0 ? dir : (t5 == 4 ? 2 + dir : 3 + t5);        \
            _Pragma("unroll") for (int j = 0; j < 2; ++j) __builtin_amdgcn_global_load_lds((const unsigned*)(sb_ + gk * 8192 + soff[j]), (LAS unsigned*)(db_ + t5 * 8192 + doff[j]), 16, 0, 0); } \
        const float* aux_ = (const float*)(p.ws + WS_GAUX) + (size_t)(cid_ * 6 + h) * GAUX_N; \
        __builtin_amdgcn_global_load_lds((const unsigned*)(aux_ + auxi), (LAS unsigned*)(AXB + (set) * 256 + tid), 4, 0, 0); \
    } while (0)
        CH_DMA(0, 0); CH_DMA(1, 1);
        asm volatile("s_waitcnt vmcnt(11)" ::: "memory");
        int ws = 2;
        for (int q = 0; q < 260; ++q) {
            __builtin_amdgcn_s_barrier(); asm volatile("" ::: "memory");
            if (q + 2 < 260) { CH_DMA(q + 2, ws); asm volatile("s_waitcnt vmcnt(11)" ::: "memory"); }
            else asm volatile("s_waitcnt vmcnt(0)" ::: "memory");
            ws = (ws == 2) ? 0 : ws + 1;
        }
#undef CH_DMA
    } else {
        int rs = 0;
        u32x4 sp0 = (u32x4){0u, 0u, 0u, 0u}, sp1 = sp0;
        for (int q = 0; q < 260; ++q) {
            const int cid = chain_cid(b, dir, q);
            asm volatile("s_waitcnt lgkmcnt(0)" ::: "memory"); __builtin_amdgcn_s_barrier(); asm volatile("" ::: "memory");
            const LAS bf16_t* tb_ = TB + rs * TSET;
            chain_compute(S, sp0, sp1, tb_, tb_ + 4096, tb_ + 2 * 4096, tb_ + 3 * 4096, AXB + rs * 256, tb_ + 4 * 4096, O, cid, h, dir, last, lane, wv, fr, fq, amask);
            rs = (rs == 2) ? 0 : rs + 1;
        }
    }
    asm volatile("s_waitcnt vmcnt(0) lgkmcnt(0)" ::: "memory"); __builtin_amdgcn_s_barrier(); asm volatile("" ::: "memory");
}

__device__ __forceinline__ void ssd_scan_unit(const Params& p, int u) {
    const int tid = LTID;
    const int part = u & 15, hh = (u >> 4) % 6, bb = ((u >> 4) / 6) & 1, dir = (u >> 4) / 12;
    unsigned* SS = (unsigned*)(p.ws + WS_RA);
    float* SSDCD = (float*)(p.ws + WS_SSDCD);
    const size_t eoff = (size_t)part * 256 + tid;
    float s0 = 0.f, s1 = 0.f;
    for (int q0 = 0; q0 < 260; q0 += 4) {
        unsigned v[4]; float cd[4]; size_t idx[4];
#pragma unroll
        for (int i = 0; i < 4; ++i) { const int cid = chain_cid(bb, dir, q0 + i);
            idx[i] = (((size_t)dir * NCHUNK + cid) * 6 + hh) * 4096 + eoff; v[i] = SS[idx[i]]; cd[i] = __hip_atomic_load(SSDCD + ((size_t)dir * NCHUNK + cid) * 6 + hh, __ATOMIC_RELAXED, __HIP_MEMORY_SCOPE_AGENT); }
#pragma unroll
        for (int i = 0; i < 4; ++i) {
            const float l0 = __uint_as_float(v[i] << 16), l1 = __uint_as_float(v[i] & 0xffff0000u);
            SS[idx[i]] = pk2(s0, s1);
            s0 = s0 * cd[i] + l0; s1 = s1 * cd[i] + l1;
        }
    }
}

constexpr int LDW = 136;
__device__ __forceinline__ void ssd_passC_unit(const Params& p, int l, int cid, int h, LAS unsigned char* lds) {
    lds = opaque_lds(lds);
    const int tid = opaque_tid(), lane = tid & 63, wv = __builtin_amdgcn_readfirstlane(tid >> 6), fr = lane & 15, fq = lane >> 4;
    const int g = h / 3;
    const bf16_t* P1 = (const bf16_t*)(p.ws + WS_RB);
    const bf16_t* SS = (const bf16_t*)(p.ws + WS_RA);
    bf16_t* YS = (bf16_t*)((unsigned char*)p.out) + (size_t)2 * NROWS * 384;
    float* SSQP = (float*)(p.ws + WS_SSQP);
    LAS bf16_t* XT = (LAS bf16_t*)lds;
    LAS bf16_t* Bs = XT + 64 * LDT;
    LAS bf16_t* Cs = Bs + 64 * LDW;
    LAS bf16_t* As = Cs + 64 * LDW;
    LAS float* SER = (LAS float*)(As + 64 * LDT);
    int t0, N; ssd_chunk_geom(cid, t0, N);
    const int row0 = cid * 64;
    bf16x8 stf[4], stb[4];
    { const bf16_t* STf = SS + (((size_t)0 * NCHUNK + cid) * 6 + h) * 8192 + (size_t)(wv * 16 + fr) * 128 + fq * 8;
      const bf16_t* STb = SS + (((size_t)1 * NCHUNK + cid) * 6 + h) * 8192 + (size_t)(wv * 16 + fr) * 128 + fq * 8;
#pragma unroll
      for (int ks = 0; ks < 4; ++ks) { stf[ks] = *(const bf16x8*)(STf + ks * 32); stb[ks] = *(const bf16x8*)(STb + ks * 32); } }
    if (wv < 2) {
        const int dir = wv;
        const float dtr = bf2f(P1[(size_t)(row0 + lane) * P1_LD + C_DT + dir * 6 + h]);
        const float dt = softplus_f(dtr + p.ssd_dt_bias[(l * 2 + dir) * 6 + h]);
        const float a = -__expf(p.ssd_a_log[(l * 2 + dir) * 6 + h]);
        SER[dir * 128 + lane] = dt; SER[dir * 128 + 64 + lane] = wave_scan_dir(dt * a, lane, dir);
    }
    for (int pass = 0; pass < 2; ++pass) {
        const int vs = pass * 32 + (tid & 31), tg = tid >> 5;
        if (vs < 40) {
            const int kind = vs < 8 ? 0 : (vs < 24 ? 1 : 2);
            const int ch = kind == 0 ? (h * 64 + vs * 8) : (kind == 1 ? (384 + g * 128 + (vs - 8) * 8) : (640 + g * 128 + (vs - 24) * 8));
            conv8_slide(P1 + C_XS + ch, P1_LD, row0 + tg * 8, 1, t0 + tg * 8, N, p.ssd_conv_w + (size_t)l * 5 * 896 + ch, 896, p.ssd_conv_b + l * 896 + ch,
                [&](int i, const float (&o)[8]) {
                    const int j = tg * 8 + i;
                    if (kind == 0) {
#pragma unroll
                        for (int e = 0; e < 8; ++e) XT[(vs * 8 + e) * LDT + j] = f2bf(o[e]); }
                    else { u32x4 w; w.x = pk2(o[0], o[1]); w.y = pk2(o[2], o[3]); w.z = pk2(o[4], o[5]); w.w = pk2(o[6], o[7]);
                        *(LAS u32x4*)((kind == 1 ? Bs : Cs) + j * LDW + (kind == 1 ? vs - 8 : vs - 24) * 8) = w; }
                });
        }
    }
    __syncthreads();
    {
        f32x4 G[4];
#pragma unroll
        for (int jt = 0; jt < 4; ++jt) G[jt] = (f32x4){0.f, 0.f, 0.f, 0.f};
#pragma unroll
        for (int ks = 0; ks < 4; ++ks) { const bf16x8 cf = ldfrag(Cs, LDW, wv * 16, ks * 32, lane);
#pragma unroll
            for (int jt = 0; jt < 4; ++jt) G[jt] = MFMA16(ldfrag(Bs, LDW, jt * 16, ks * 32, lane), cf, G[jt]); }
        const int irow = wv * 16 + fr;
        const LAS float* dtf = SER; const LAS float* acf = SER + 64; const LAS float* dtb = SER + 128; const LAS float* acb = SER + 192;
        const float acf_i = acf[irow], acb_i = acb[irow];
#pragma unroll
        for (int jt = 0; jt < 4; ++jt) {
            float a[4];
#pragma unroll
            for (int r = 0; r < 4; ++r) { const int j = jt * 16 + 4 * fq + r; float c = 0.f;
                if (j <= irow) c += __expf(acf_i - acf[j]) * dtf[j];
                if (j >= irow) c += __expf(acb_i - acb[j]) * dtb[j];
                a[r] = G[jt][r] * c; }
            u32x2 w; w.x = pk2(a[0], a[1]); w.y = pk2(a[2], a[3]);
            *(LAS u32x2*)(As + irow * LDT + jt * 16 + 4 * fq) = w;
        }
    }
    __syncthreads();
    {
        const bf16x8 xf0 = ldfrag(XT, LDT, wv * 16, 0, lane), xf1 = ldfrag(XT, LDT, wv * 16, 32, lane);
        const float dsk = p.ssd_d[l * 6 + h];
#pragma unroll
        for (int it = 0; it < 4; ++it) {
            f32x4 y = (f32x4){0.f, 0.f, 0.f, 0.f}, yf = y, yb = y;
            y = MFMA16(xf0, ldfrag(As, LDT, it * 16, 0, lane), y);
            y = MFMA16(xf1, ldfrag(As, LDT, it * 16, 32, lane), y);
#pragma unroll
            for (int ks = 0; ks < 4; ++ks) { const bf16x8 cf = ldfrag(Cs, LDW, it * 16, ks * 32, lane); yf = MFMA16(stf[ks], cf, yf); yb = MFMA16(stb[ks], cf, yb); }
            const int i = it * 16 + fr;
            const size_t grow = (size_t)(row0 + i);
            const float eaf = __expf(SER[64 + i]), eab = __expf(SER[192 + i]);
            const u32x2 zw = *(const u32x2*)(P1 + grow * P1_LD + C_Z + h * 64 + wv * 16 + 4 * fq);
            const float z[4] = {__uint_as_float(zw.x << 16), __uint_as_float(zw.x & 0xffff0000u), __uint_as_float(zw.y << 16), __uint_as_float(zw.y & 0xffff0000u)};
            float o[4], ssq = 0.f;
#pragma unroll
            for (int r = 0; r < 4; ++r) { const float xv = bf2f(XT[(wv * 16 + 4 * fq + r) * LDT + i]);
                o[r] = (y[r] + eaf * yf[r] + eab * yb[r] + dsk * xv) * silu_f(z[r]);
                const float ob = bf2f(f2bf(o[r])); ssq += ob * ob; }
            u32x2 w; w.x = pk2(o[0], o[1]); w.y = pk2(o[2], o[3]);
            *(u32x2*)(YS + grow * 384 + h * 64 + wv * 16 + 4 * fq) = w;
            ssq += __shfl_xor(ssq, 16); ssq += __shfl_xor(ssq, 32);
            if (fq == 0) SSQP[grow * 24 + h * 4 + wv] = ssq;
        }
    }
    __syncthreads();
}

constexpr int N_CHAIN_WG = 24;
__device__ __forceinline__ void phase_chain(const Params& p, int l, LAS unsigned char* lds, LAS unsigned char* ldsh, const XcdBarrier& side) {
    if (blockIdx.x < N_CHAIN_WG) {
        const int reps =
#if defined(REPEAT_CHAIN)
            2;
#else
            1;
#endif
        for (int rp = 0; rp < reps; ++rp) {
            gdn_chain(p, l, blockIdx.x, lds, (VB & 1) != 0);
        }
        return; }
    phase_inproj<1>(p, l, lds, blockIdx.x - N_CHAIN_WG, gridDim.x - N_CHAIN_WG);
    xcd_barrier(side);
    const int nb = NVB - 2 * N_CHAIN_WG, me = VB - 2 * N_CHAIN_WG;
    const int it_a = (SP_SSD_UNITS + nb - 1) / nb;
    for (int it = 0; it < it_a; ++it) { int u = me + it * nb; if (u >= SP_SSD_UNITS) u = SP_SSD_UNITS - 1; ssd_passA_unit(p, l, u >> 1, u & 1, ldsh); }
    xcd_barrier(side);
    for (int u = me; u < 384; u += nb) ssd_scan_unit(p, u);
    xcd_barrier(side);
    const int nu = ((l == NL - 1) ? 512 : NCHUNK) * 6;
    const int it_c = (nu + nb - 1) / nb;
    for (int it = 0; it < it_c; ++it) { int u = me + it * nb; if (u >= nu) u = nu - 1; ssd_passC_unit(p, l, u / 6, u % 6, ldsh); }
}

__device__ __forceinline__ const float* ldp(const LAS unsigned* s, int i) {
    const unsigned lo = __builtin_amdgcn_readfirstlane(s[2 * i]), hi = __builtin_amdgcn_readfirstlane(s[2 * i + 1]);
    return (const float*)(((unsigned long long)hi << 32) | (unsigned long long)lo);
}
__device__ __forceinline__ Params load_params(const LAS unsigned* s) {
    Params q;
    q.x = ldp(s, 0); q.c = ldp(s, 1); q.ctx = ldp(s, 2); q.c_ctx = ldp(s, 3); q.norm1_g = ldp(s, 4); q.norm2_g = ldp(s, 5); q.ada_w = ldp(s, 6); q.ada_b = ldp(s, 7);
    q.w_in = ldp(s, 8); q.w_out = ldp(s, 9); q.pool_w = ldp(s, 10); q.pool_scale = ldp(s, 11); q.ssd_conv_w = ldp(s, 12); q.ssd_conv_b = ldp(s, 13); q.ssd_a_log = ldp(s, 14);
    q.ssd_dt_bias = ldp(s, 15); q.ssd_d = ldp(s, 16); q.ssd_norm_g = ldp(s, 17); q.gdn_conv_w = ldp(s, 18); q.gdn_a_log = ldp(s, 19); q.gdn_dt_bias = ldp(s, 20); q.gdn_norm_g = ldp(s, 21);
    q.router_w = ldp(s, 22); q.exp_w_gate = ldp(s, 23); q.exp_w_up = ldp(s, 24); q.exp_w_down = ldp(s, 25); q.final_norm_g = ldp(s, 26);
    q.out = (float*)ldp(s, 27); q.ws = (unsigned char*)ldp(s, 28); q.ph_lo = 0; q.ph_hi = 0;
    return q;
}

constexpr int PH_PER_LAYER = 10;
constexpr int N_PHASES = 2 + PH_PER_LAYER * NL;

__global__ void __launch_bounds__(WG_THREADS, 2) mega(const Params pk) {
    extern __shared__ __attribute__((aligned(16))) unsigned char smem[];
    LAS unsigned char* lds = (LAS unsigned char*)smem;
    LAS unsigned char* ldsh = lds + __builtin_amdgcn_readfirstlane((int)(threadIdx.x >> 8)) * LDS_HALF;
    volatile LAS unsigned* xbw = (volatile LAS unsigned*)(lds + LDS_BYTES);
    if (threadIdx.x < 4) xbw[threadIdx.x] = 0u;
    __syncthreads();
    const int lo = __builtin_amdgcn_readfirstlane(pk.ph_lo), hi = __builtin_amdgcn_readfirstlane(pk.ph_hi);
    const bool multi = (hi - lo) > 1;
    unsigned* barw = (unsigned*)(pk.ws + WS_CTL);
    XcdBarrier bar; bar.bar = barw; bar.x = 0; bar.st = xbw; bar.G = gridDim.x;
    if (multi) bar = xcd_barrier_post(barw, xbw, gridDim.x);
    XcdBarrier side; side.bar = (unsigned*)(pk.ws + WS_CTL2); side.x = 0; side.st = xbw + 2; side.G = gridDim.x - N_CHAIN_WG;
    if (blockIdx.x >= N_CHAIN_WG) side = xcd_barrier_post((unsigned*)(pk.ws + WS_CTL2), xbw + 2, gridDim.x - N_CHAIN_WG);
#ifndef REPEAT_MASK
#define REPEAT_MASK 0u
#endif
#define PH_KIND(ph) ((ph) == 0 ? 12 : ((ph) == 1 ? 13 : (((ph) - 2) % PH_PER_LAYER)))
#define RUN_PH(ph, call) if (lo <= (ph) && (ph) < hi) { { const Params& p = pk; call; if ((REPEAT_MASK >> PH_KIND(ph)) & 1u) { __syncthreads(); call; } } if ((ph) + 1 < hi) xcd_barrier(bar); }
    RUN_PH(0, phase0(p, ldsh))
    RUN_PH(1, phase_norm1(p))
#define RUN_LAYER(l) \
    RUN_PH(2 + PH_PER_LAYER * (l) + 0, (phase_inproj<0>(p, (l), lds, blockIdx.x, gridDim.x))) \
    RUN_PH(2 + PH_PER_LAYER * (l) + 1, phase_gdn_prep(p, (l), ldsh)) \
    RUN_PH(2 + PH_PER_LAYER * (l) + 2, phase_chain(p, (l), lds, ldsh, side)) \
    RUN_PH(2 + PH_PER_LAYER * (l) + 3, phase_post_tok(p, (l))) \
    RUN_PH(2 + PH_PER_LAYER * (l) + 4, phase_outproj(p, (l), lds)) \
    RUN_PH(2 + PH_PER_LAYER * (l) + 5, phase_norm2_router(p, (l), ldsh)) \
    RUN_PH(2 + PH_PER_LAYER * (l) + 6, phase_topk_conv(p, (l), ldsh)) \
    RUN_PH(2 + PH_PER_LAYER * (l) + 7, phase_exp1(p, (l), lds)) \
    RUN_PH(2 + PH_PER_LAYER * (l) + 8, phase_exp2(p, (l), lds)) \
    RUN_PH(2 + PH_PER_LAYER * (l) + 9, phase_combine(p, (l)))
    RUN_LAYER(0)
    RUN_LAYER(1)
}

#ifndef N_LAUNCH_MODE
#define N_LAUNCH_MODE 1
#endif
extern "C" void kernel_launch(void* const* d_in, const int* in_sizes, int n_in, void* d_out, int out_size, void* d_ws, size_t ws_size, hipStream_t stream) {
    static int grid = 0;
    const size_t lds_total = LDS_BYTES + 16;
    if (grid == 0) {
        if (n_in != 27 || ws_size < WS_END) { fprintf(stderr, "kernel_launch: unexpected n_in %d or ws_size %zu (need %zu)\n", n_in, ws_size, (size_t)WS_END); grid = -1; return; }
        int dev = 0, cus = 0, per_cu = 0;
        (void)hipGetDevice(&dev); (void)hipDeviceGetAttribute(&cus, hipDeviceAttributeMultiprocessorCount, dev);
        (void)hipFuncSetAttribute((const void*)mega, hipFuncAttributeMaxDynamicSharedMemorySize, (int)lds_total);
        (void)hipOccupancyMaxActiveBlocksPerMultiprocessor(&per_cu, (const void*)mega, WG_THREADS, lds_total);
        if (per_cu < 1) { fprintf(stderr, "kernel_launch: occupancy query returned %d\n", per_cu); grid = -1; return; }
        if (per_cu > 1) per_cu = 1;
        grid = cus * per_cu;
        fprintf(stderr, "kernel_launch: cus %d per_cu %d grid %d ws %zu need %zu\n", cus, per_cu, grid, ws_size, (size_t)WS_END);
    }
    if (grid < 0) return;
    Params p{};
    const float** pp = (const float**)&p;
    for (int i = 0; i < 27; ++i) pp[i] = (const float*)d_in[i];
    p.out = (float*)d_out; p.ws = (unsigned char*)d_ws;
    (void)hipMemsetAsync((char*)d_ws + WS_CTL, 0, 32768, stream);
#if N_LAUNCH_MODE == 1
    p.ph_lo = 0; p.ph_hi = N_PHASES;
    void* args[] = {&p};
    hipError_t e = hipLaunchCooperativeKernel((const void*)mega, dim3(grid), dim3(WG_THREADS), args, lds_total, stream);
    if (e != hipSuccess) fprintf(stderr, "cooperative launch failed: %s (grid %d)\n", hipGetErrorString(e), grid);
#else
    for (int ph = 0; ph < N_PHASES; ++ph) {
        p.ph_lo = ph; p.ph_hi = ph + 1;
        hipLaunchKernelGGL(mega, dim3(grid), dim3(WG_THREADS), lds_total, stream, p);
    }
#endif
}
```

```cpp
#include <hip/hip_runtime.h>
#include <hip/hip_cooperative_groups.h>
#include <cstdio>
#include <cstdint>

#define LAS __attribute__((address_space(3)))
typedef unsigned short bf16_t;
typedef short bf16x8 __attribute__((ext_vector_type(8)));
typedef float f32x4 __attribute__((ext_vector_type(4)));
typedef unsigned u32x4 __attribute__((ext_vector_type(4)));
typedef unsigned u32x2 __attribute__((ext_vector_type(2)));
typedef float f32x2 __attribute__((ext_vector_type(2)));

constexpr int D = 1024, NB = 2, T = 16384, TC = 256, NLAT = NB * T, NROWS = NLAT + NB * TC;
constexpr int NL = 2;
constexpr int IN_DIM = 3108, NPAD = 3328;
constexpr int P1_LD = 1960, P2_LD = 1152;
constexpr int C_U = 0, C_Z = 256, C_XS = 640, C_BM = 1024, C_CM = 1280, C_DT = 1536, C_GATE = 1548, C_AR = 1932, C_BR = 1944;
constexpr int NCHUNK = 520;
constexpr int NE = 16, FF = 512, CAP_L = 2048, CAP_C = 32;
constexpr float EPS = 1e-6f;
constexpr int NTHR = 256;
constexpr int WG_THREADS = 512;
constexpr int LDS_HALF = 78 * 1024;
constexpr int LDS_BYTES = 2 * LDS_HALF;
#define LTID ((int)(threadIdx.x & 255))
#define VB ((int)(blockIdx.x * 2 + __builtin_amdgcn_readfirstlane((int)(threadIdx.x >> 8))))
#define NVB ((int)(gridDim.x * 2))
#define PADDED_ITERS(n) (((n) + NVB - 1) / NVB)

constexpr size_t al256(size_t x) { return (x + 255) & ~(size_t)255; }
constexpr size_t WS_CTL = 0;
constexpr size_t WS_CTL2 = 16384;
constexpr size_t WS_MOD = 32768;
constexpr size_t WS_WIN = al256(WS_MOD + (size_t)NL * 3 * 6144 * 4);
constexpr size_t WS_WOUT = WS_WIN + (size_t)NL * NPAD * D * 2;
constexpr size_t WS_CTXX = WS_WOUT + (size_t)NL * D * D * 2;
constexpr size_t WS_AFF = WS_CTXX + (size_t)NB * TC * D * 4;
constexpr size_t WS_SELIDX = WS_AFF + (size_t)NB * NE * (T + TC) * 4;
constexpr size_t WS_SELGATE = WS_SELIDX + (size_t)NB * NE * (CAP_L + CAP_C) * 4;
constexpr size_t WS_SLOT = WS_SELGATE + (size_t)NB * NE * (CAP_L + CAP_C) * 4;
constexpr size_t WS_SSDCD = WS_SLOT + (size_t)NROWS * NE * 4;
constexpr size_t WS_GAUX = al256(WS_SSDCD + (size_t)2 * NCHUNK * 6 * 4);
constexpr int GAUX_N = 272;
constexpr size_t WS_SSQP = al256(WS_GAUX + (size_t)NCHUNK * 6 * GAUX_N * 4);
constexpr size_t WS_RA = al256(WS_SSQP + (size_t)NROWS * 24 * 4);
constexpr size_t RA_BYTES = (size_t)2 * NCHUNK * 6 * 8192 * 2;
constexpr size_t WS_RB = WS_RA + RA_BYTES;
constexpr size_t RB_BYTES = (size_t)NROWS * P1_LD * 2;
constexpr size_t WS_XB = WS_RB + RB_BYTES;
constexpr size_t WS_RC = WS_XB;
constexpr size_t RC_BYTES = (size_t)NROWS * P2_LD * 2;
constexpr size_t WS_RD = WS_RC + RC_BYTES;
constexpr size_t GPREP_BYTES = 57344;
constexpr size_t RD_BYTES = (size_t)NCHUNK * 6 * GPREP_BYTES;
constexpr size_t WS_END = WS_RD + RD_BYTES;
static_assert(WS_END <= (size_t)536870912, "workspace layout exceeds 512 MiB");
static_assert((size_t)NROWS * D * 2 <= RC_BYTES, "XB fits the old region C slot");
static_assert(RC_BYTES <= (size_t)NLAT * D * 4, "region C fits d_out");
constexpr size_t PART_OFF = (RC_BYTES + 255) / 256 * 256;
constexpr int OP_KS = 8;
static_assert(PART_OFF + (size_t)OP_KS * NB * TC * D * 4 <= (size_t)NLAT * D * 4, "out-proj partials fit d_out");
static_assert((size_t)NROWS * D * 2 <= RA_BYTES, "H fits region A");
static_assert((size_t)3 * NROWS * 384 * 2 <= RC_BYTES, "O_f, O_b and the SSD output fit region C");
static_assert((size_t)NE * D * D * 2 + (size_t)NE * D * FF * 2 <= RC_BYTES, "Wexp fits region C");
static_assert((size_t)NB * NE * (CAP_L + CAP_C) * FF * 2 <= RB_BYTES, "HID fits region B");
static_assert((size_t)NB * NE * (CAP_L + CAP_C) * D * 2 <= RD_BYTES, "YE fits region D");

struct Params {
    const float *x, *c, *ctx, *c_ctx, *norm1_g, *norm2_g, *ada_w, *ada_b, *w_in, *w_out, *pool_w, *pool_scale,
        *ssd_conv_w, *ssd_conv_b, *ssd_a_log, *ssd_dt_bias, *ssd_d, *ssd_norm_g, *gdn_conv_w, *gdn_a_log, *gdn_dt_bias, *gdn_norm_g,
        *router_w, *exp_w_gate, *exp_w_up, *exp_w_down, *final_norm_g;
    float* out; unsigned char* ws; int ph_lo, ph_hi;
};

typedef __bf16 bf16x2_t __attribute__((ext_vector_type(2)));
__device__ __forceinline__ bf16_t f2bf(float f) { const __bf16 h = (__bf16)f; return __builtin_bit_cast(bf16_t, h); }
__device__ __forceinline__ float bf2f(bf16_t h) { return __uint_as_float(((unsigned)h) << 16); }
__device__ __forceinline__ unsigned pk2(float lo, float hi) { const bf16x2_t v = __builtin_convertvector((f32x2){lo, hi}, bf16x2_t); return __builtin_bit_cast(unsigned, v); }
__device__ __forceinline__ float silu_f(float x) { return x * __builtin_amdgcn_rcpf(1.f + __expf(-x)); }
__device__ __forceinline__ float softplus_f(float x) { return fmaxf(x, 0.f) + log1pf(__expf(-fabsf(x))); }
__device__ __forceinline__ float sigmoid_f(float x) { return __builtin_amdgcn_rcpf(1.f + __expf(-x)); }
__device__ __forceinline__ float wave_sum(float v) {
#pragma unroll
    for (int o = 32; o > 0; o >>= 1) v += __shfl_xor(v, o);
    return v;
}
#define MFMA16(a, b, c) __builtin_amdgcn_mfma_f32_16x16x32_bf16((a), (b), (c), 0, 0, 0)
__device__ __forceinline__ bf16x8 ldfrag(const LAS bf16_t* base, int ld, int r0, int k0, int lane) {
    return *(const LAS bf16x8*)(base + (r0 + (lane & 15)) * ld + k0 + 8 * (lane >> 4));
}
__device__ __forceinline__ void unpack8(const u32x4 v, float* f) {
    f[0] = __uint_as_float(v.x << 16); f[1] = __uint_as_float(v.x & 0xffff0000u);
    f[2] = __uint_as_float(v.y << 16); f[3] = __uint_as_float(v.y & 0xffff0000u);
    f[4] = __uint_as_float(v.z << 16); f[5] = __uint_as_float(v.z & 0xffff0000u);
    f[6] = __uint_as_float(v.w << 16); f[7] = __uint_as_float(v.w & 0xffff0000u);
}

__device__ __forceinline__ LAS unsigned char* opaque_lds(LAS unsigned char* p) { asm volatile("" : "+v"(p)); return p; }
__device__ __forceinline__ LAS unsigned char* opaque_lds_s(LAS unsigned char* p) { unsigned v = (unsigned)(unsigned long long)p; v = (unsigned)__builtin_amdgcn_readfirstlane((int)v); asm volatile("" : "+s"(v)); return (LAS unsigned char*)(unsigned long long)v; }
__device__ __forceinline__ int opaque_tid() { int t = LTID; asm volatile("" : "+v"(t)); return t; }

#define XB_TMO      128
#define XB_XCNT(j)  (256  + 64 * (j))
#define XB_XSUB(j)  (1280 + 64 * (j))
#define XB_XGEN(j)  (2304 + 64 * (j))
#define XB_TOP      3328
#define XB_TOPGEN   3392
#define XCD_BAR_WORDS 3456
#define XB_SPIN_CAP (1u << 22)
__device__ __forceinline__ unsigned xb_ld(unsigned* p)              { return __hip_atomic_load(p, __ATOMIC_RELAXED, __HIP_MEMORY_SCOPE_AGENT); }
__device__ __forceinline__ unsigned xb_add(unsigned* p, unsigned v) { return __hip_atomic_fetch_add(p, v, __ATOMIC_RELAXED, __HIP_MEMORY_SCOPE_AGENT); }
__device__ __forceinline__ unsigned xb_xcc_id() { return (unsigned)__builtin_amdgcn_s_getreg((3 << 11) | 20) & 0xFu; }
#define XB_SPIN(cond, bar) do { unsigned _sp = 0; while (cond) { __builtin_amdgcn_s_sleep(1); \
    if ((++_sp & 255u) == 0u) { if (xb_ld(&(bar)[XB_TMO])) break; if (_sp > XB_SPIN_CAP) { atomicAdd(&(bar)[XB_TMO], 1u); break; } } } } while (0)
struct XcdBarrier { unsigned* bar; unsigned x; volatile LAS unsigned* st; unsigned G; };
__device__ __forceinline__ XcdBarrier xcd_barrier_post(unsigned* bar, volatile LAS unsigned* st, unsigned G) {
    XcdBarrier b; b.bar = bar; b.x = xb_xcc_id(); b.st = st; b.G = G;
    if (threadIdx.x == 0) (void)xb_add(&bar[XB_XCNT(b.x)], 1u);
    return b;
}
__device__ __forceinline__ void xcd_barrier_complete(unsigned* bar, unsigned x, unsigned G, unsigned& nloc, unsigned& nx) {
    unsigned sum, cnt, mine, sp = 0u;
    for (;;) {
        sum = 0u; cnt = 0u; mine = 0u;
#pragma unroll
        for (unsigned j = 0; j < 16; ++j) { const unsigned c = xb_ld(&bar[XB_XCNT(j)]); sum += c; cnt += (c > 0u) ? 1u : 0u; mine = (j == x) ? c : mine; }
        if (sum == G) break;
        __builtin_amdgcn_s_sleep(1);
        if ((++sp & 255u) == 0u) { if (xb_ld(&bar[XB_TMO])) break; if (sp > XB_SPIN_CAP) { atomicAdd(&bar[XB_TMO], 1u); break; } }
    }
    nloc = mine > 0u ? mine : 1u; nx = cnt > 0u ? cnt : 1u;
}
__device__ __forceinline__ void xcd_barrier(const XcdBarrier& b) {
    asm volatile("s_waitcnt vmcnt(0)" ::: "memory");
    __syncthreads();
    if (threadIdx.x == 0) {
        unsigned* bar = b.bar;
        __builtin_amdgcn_s_waitcnt(0);
        unsigned nloc = b.st[0], nx = b.st[1];
        if (nloc == 0u) { xcd_barrier_complete(bar, b.x, b.G, nloc, nx); b.st[0] = nloc; b.st[1] = nx; }
        const unsigned old = xb_add(&bar[XB_XSUB(b.x)], 1u);
        const unsigned gen = old / nloc;
        if (old + 1u == (gen + 1u) * nloc) {
            __builtin_amdgcn_fence(__ATOMIC_RELEASE, "agent");
            asm volatile("s_waitcnt vmcnt(0)" ::: "memory");
            const unsigned og = xb_add(&bar[XB_TOP], 1u);
            const unsigned tg = og / nx;
            if (og + 1u == (tg + 1u) * nx) xb_add(&bar[XB_TOPGEN], 1u);
            else XB_SPIN(xb_ld(&bar[XB_TOPGEN]) == tg, bar);
            __builtin_amdgcn_fence(__ATOMIC_ACQUIRE, "agent");
            xb_add(&bar[XB_XGEN(b.x)], 1u);
            asm volatile("s_waitcnt vmcnt(0)" ::: "memory");
        } else {
            XB_SPIN(xb_ld(&bar[XB_XGEN(b.x)]) == gen, bar);
            __builtin_amdgcn_fence(__ATOMIC_ACQUIRE, "agent");
            asm volatile("s_waitcnt vmcnt(0)" ::: "memory");
        }
    }
    __syncthreads();
}

__device__ __forceinline__ size_t kb_off(size_t row, int col, size_t nrows) { return ((size_t)(col >> 5) * nrows + row) * 32 + (col & 31); }

__device__ __forceinline__ int row_mset(int row) { return row < T ? 0 : (row < NLAT ? 1 : 2); }
__device__ __forceinline__ int gdn_pos_row(int set, int p) {
    if (set >= 2) return NLAT + (set - 2) * TC + p;
    return set * T + (p & 255) * 64 + (p >> 8);
}

__device__ __forceinline__ int winmap(int n) {
    if (n < 1152) return 1548 + n;
    if (n < 1176) return 3084 + (n - 1152);
    if (n < 1280) return -1;
    if (n < 2828) return n - 1280;
    if (n < 3212) return 2700 + (n - 2828);
    return -1;
}

constexpr int P0_NWIN = NL * 52 * 16, P0_NWOUT = NL * 16 * 16, P0_NADA = NL * (6144 / 32);
constexpr int P0_UNITS = P0_NWIN + P0_NWOUT + P0_NADA;

__device__ __forceinline__ void phase0(const Params& p, LAS unsigned char* lds) {
    const int tid = LTID;
    LAS float* tile = (LAS float*)lds;
    LAS float* tile2 = tile + 64 * 65;
    bf16_t* WinT = (bf16_t*)(p.ws + WS_WIN);
    bf16_t* WoutT = (bf16_t*)(p.ws + WS_WOUT);
    float* MOD = (float*)(p.ws + WS_MOD);
    for (int it = 0; it < PADDED_ITERS(P0_NWIN); ++it) { int u = VB + it * NVB; if (u >= P0_NWIN) u = P0_NWIN - 1;
        {
            const int l = u / 832, r = u % 832, nt = r / 16, kt = r % 16;
            const float* src = p.w_in + (size_t)l * D * IN_DIM;
            for (int e = tid; e < 1024; e += NTHR) { const int k = e >> 4, n = (e & 15) * 4; const int gn = winmap(nt * 64 + n);
                f32x4 v4 = (f32x4){0.f, 0.f, 0.f, 0.f};
                if (gn >= 0) v4 = *(const f32x4*)(src + (size_t)(kt * 64 + k) * IN_DIM + gn);
                tile[k * 65 + n] = v4[0]; tile[k * 65 + n + 1] = v4[1]; tile[k * 65 + n + 2] = v4[2]; tile[k * 65 + n + 3] = v4[3]; }
            __syncthreads();
            { const int n = tid >> 2, k0 = (tid & 3) * 16; u32x4 w0, w1; float f[16];
#pragma unroll
              for (int j = 0; j < 16; ++j) f[j] = tile[(k0 + j) * 65 + n];
              w0.x = pk2(f[0], f[1]); w0.y = pk2(f[2], f[3]); w0.z = pk2(f[4], f[5]); w0.w = pk2(f[6], f[7]);
              w1.x = pk2(f[8], f[9]); w1.y = pk2(f[10], f[11]); w1.z = pk2(f[12], f[13]); w1.w = pk2(f[14], f[15]);
              bf16_t* dst = WinT + (size_t)l * NPAD * D + kb_off(nt * 64 + n, kt * 64 + k0, NPAD);
              *(u32x4*)dst = w0; *(u32x4*)(dst + 8) = w1; }
            __syncthreads();
        }
    }
    for (int it = 0; it < PADDED_ITERS(P0_NWOUT); ++it) { int v = VB + it * NVB; if (v >= P0_NWOUT) v = P0_NWOUT - 1;
        {
            const int l = v / 256, r = v % 256, nt = r / 16, kt = r % 16;
            const float* src = p.w_out + (size_t)l * D * D;
            for (int e = tid; e < 1024; e += NTHR) { const int k = e >> 4, n = (e & 15) * 4; const f32x4 v4 = *(const f32x4*)(src + (size_t)(kt * 64 + k) * D + nt * 64 + n);
                tile[k * 65 + n] = v4[0]; tile[k * 65 + n + 1] = v4[1]; tile[k * 65 + n + 2] = v4[2]; tile[k * 65 + n + 3] = v4[3]; }
            if (kt < 4) {
                const float* pw = p.pool_w + ((size_t)l * 4 + kt) * 4096; const float* ps = p.pool_scale + l * 256 + kt * 64;
                for (int e = tid; e < 4096; e += NTHR) { const int c = e >> 6, d = e & 63; tile2[c * 65 + d] = pw[c * 64 + d] * ps[d]; }
            }
            __syncthreads();
            float acc[16];
            const int nn = tid & 63, c0 = (tid >> 6) * 16;
            if (kt < 4) {
#pragma unroll
                for (int j = 0; j < 16; ++j) acc[j] = 0.f;
                for (int d = 0; d < 64; ++d) { const float w = tile[d * 65 + nn];
#pragma unroll
                    for (int j = 0; j < 16; ++j) acc[j] += tile2[(c0 + j) * 65 + d] * w; }
            }
            __syncthreads();
            if (kt < 4) {
#pragma unroll
                for (int j = 0; j < 16; ++j) tile[(c0 + j) * 65 + nn] = acc[j];
            }
            __syncthreads();
            { const int n = tid >> 2, k0 = (tid & 3) * 16; u32x4 w0, w1; float f[16];
#pragma unroll
              for (int j = 0; j < 16; ++j) f[j] = tile[(k0 + j) * 65 + n];
              w0.x = pk2(f[0], f[1]); w0.y = pk2(f[2], f[3]); w0.z = pk2(f[4], f[5]); w0.w = pk2(f[6], f[7]);
              w1.x = pk2(f[8], f[9]); w1.y = pk2(f[10], f[11]); w1.z = pk2(f[12], f[13]); w1.w = pk2(f[14], f[15]);
              bf16_t* dst = WoutT + (size_t)l * D * D + kb_off(nt * 64 + n, kt * 64 + k0, D);
              *(u32x4*)dst = w0; *(u32x4*)(dst + 8) = w1; }
            __syncthreads();
        }
    }
    for (int it = 0; it < PADDED_ITERS(P0_NADA); ++it) { int v = VB + it * NVB; if (v >= P0_NADA) v = P0_NADA - 1;
        {
            const int l = v / 192, cg = v % 192;
            const int col = cg * 32 + (tid & 31), kg = tid >> 5;
            const float* aw = p.ada_w + (size_t)l * D * 6144;
            LAS float* sv = tile2;
            for (int i = tid; i < 3 * D; i += NTHR) sv[i] = silu_f(i < 2 * D ? p.c[i] : p.c_ctx[i - 2 * D]);
            __syncthreads();
            float a0 = 0.f, a1 = 0.f, a2 = 0.f;
#pragma unroll 8
            for (int k = kg * 128; k < kg * 128 + 128; ++k) {
                const float w = aw[(size_t)k * 6144 + col];
                a0 += sv[k] * w; a1 += sv[D + k] * w; a2 += sv[2 * D + k] * w;
            }
            tile[(kg * 3 + 0) * 32 + (tid & 31)] = a0; tile[(kg * 3 + 1) * 32 + (tid & 31)] = a1; tile[(kg * 3 + 2) * 32 + (tid & 31)] = a2;
            __syncthreads();
            if (tid < 96) { const int s = tid >> 5, cc = tid & 31; float sum = p.ada_b[l * 6144 + cg * 32 + cc];
                for (int g = 0; g < 8; ++g) sum += tile[(g * 3 + s) * 32 + cc];
                MOD[((size_t)l * 3 + s) * 6144 + cg * 32 + cc] = sum; }
            __syncthreads();
        }
    }
}

__device__ __forceinline__ void load_row(const float* xr, int lane, float (&v)[16]) {
#pragma unroll
    for (int j = 0; j < 4; ++j) { const f32x4 t = *(const f32x4*)(xr + j * 256 + lane * 4); v[4 * j] = t[0]; v[4 * j + 1] = t[1]; v[4 * j + 2] = t[2]; v[4 * j + 3] = t[3]; }
}
__device__ __forceinline__ void norm_mod(const float (&v)[16], const float* g, const float* shift, const float* scale, int lane, float (&h)[16]) {
    float ss = 0.f;
#pragma unroll
    for (int j = 0; j < 16; ++j) ss += v[j] * v[j];
    ss = wave_sum(ss);
    const float rstd = rsqrtf(ss * (1.f / D) + EPS);
#pragma unroll
    for (int j = 0; j < 4; ++j) { const int c = j * 256 + lane * 4;
        const f32x4 gg = *(const f32x4*)(g + c), sh = *(const f32x4*)(shift + c), sc = *(const f32x4*)(scale + c);
#pragma unroll
        for (int e = 0; e < 4; ++e) h[4 * j + e] = v[4 * j + e] * rstd * gg[e] * (1.f + sc[e]) + sh[e]; }
}
__device__ __forceinline__ void store_row_bf16(bf16_t* hr, int lane, const float (&h)[16]) {
#pragma unroll
    for (int j = 0; j < 4; ++j) { u32x2 w; w.x = pk2(h[4 * j], h[4 * j + 1]); w.y = pk2(h[4 * j + 2], h[4 * j + 3]); *(u32x2*)(hr + j * 256 + lane * 4) = w; }
}

__device__ __forceinline__ void load_rows4(const float* xr, int lane, float (&v)[4][16]) {
#pragma unroll
    for (int r = 0; r < 4; ++r)
#pragma unroll
        for (int j = 0; j < 4; ++j) { const f32x4 t = *(const f32x4*)(xr + (size_t)r * D + j * 256 + lane * 4); v[r][4 * j] = t[0]; v[r][4 * j + 1] = t[1]; v[r][4 * j + 2] = t[2]; v[r][4 * j + 3] = t[3]; }
}
__device__ __forceinline__ void load_rows4_bf16(const bf16_t* xr, int lane, float (&v)[4][16]) {
    u32x2 w[4][4];
#pragma unroll
    for (int r = 0; r < 4; ++r)
#pragma unroll
        for (int j = 0; j < 4; ++j) w[r][j] = *(const u32x2*)(xr + (size_t)r * D + j * 256 + lane * 4);
#pragma unroll
    for (int r = 0; r < 4; ++r)
#pragma unroll
        for (int j = 0; j < 4; ++j) { v[r][4 * j] = __uint_as_float(w[r][j].x << 16); v[r][4 * j + 1] = __uint_as_float(w[r][j].x & 0xffff0000u); v[r][4 * j + 2] = __uint_as_float(w[r][j].y << 16); v[r][4 * j + 3] = __uint_as_float(w[r][j].y & 0xffff0000u); }
}
__device__ __forceinline__ void norm_mod4(float (&v)[4][16], const float* g, const float* shift, const float* scale, int lane) {
    float ss[4];
#pragma unroll
    for (int r = 0; r < 4; ++r) { float t = 0.f;
#pragma unroll
        for (int j = 0; j < 16; ++j) t += v[r][j] * v[r][j];
        ss[r] = t; }
#pragma unroll
    for (int o = 32; o > 0; o >>= 1) {
#pragma unroll
        for (int r = 0; r < 4; ++r) ss[r] += __shfl_xor(ss[r], o); }
    float rstd[4];
#pragma unroll
    for (int r = 0; r < 4; ++r) rstd[r] = rsqrtf(ss[r] * (1.f / D) + EPS);
#pragma unroll
    for (int j = 0; j < 4; ++j) { const int c = j * 256 + lane * 4;
        const f32x4 gg = *(const f32x4*)(g + c), sh = *(const f32x4*)(shift + c), sc = *(const f32x4*)(scale + c);
#pragma unroll
        for (int e = 0; e < 4; ++e) { const float a = gg[e] * (1.f + sc[e]);
#pragma unroll
            for (int r = 0; r < 4; ++r) v[r][4 * j + e] = v[r][4 * j + e] * rstd[r] * a + sh[e]; } }
}
__device__ __forceinline__ void store_rows4_bf16(bf16_t* base, size_t row0, int lane, const float (&h)[4][16]) {
#pragma unroll
    for (int r = 0; r < 4; ++r)
#pragma unroll
        for (int j = 0; j < 4; ++j) { u32x2 w; w.x = pk2(h[r][4 * j], h[r][4 * j + 1]); w.y = pk2(h[r][4 * j + 2], h[r][4 * j + 3]); *(u32x2*)(base + kb_off(row0 + r, j * 256 + lane * 4, NROWS)) = w; }
}

__device__ __forceinline__ void phase_norm1(const Params& p) {
    const int lane = LTID & 63, wv = __builtin_amdgcn_readfirstlane(LTID >> 6);
    bf16_t* H = (bf16_t*)(p.ws + WS_RA);
    const float* MOD = (const float*)(p.ws + WS_MOD);
    for (int u = VB; u < NROWS / 16; u += NVB) {
        const int row = u * 16 + wv * 4;
        const float* xr = row < NLAT ? p.x + (size_t)row * D : p.ctx + (size_t)(row - NLAT) * D;
        const float* m = MOD + (size_t)(0 * 3 + row_mset(row)) * 6144;
        float v[4][16]; load_rows4(xr, lane, v);
        norm_mod4(v, p.norm1_g, m, m + D, lane);
        store_rows4_bf16(H, (size_t)row, lane, v);
    }
}

#define PAIR16_COL(fq) (16 * ((fq) & 1) + 8 * ((fq) >> 1))
__device__ __forceinline__ u32x4 pack_pair16(float a0, float a1, float a2, float a3, float b0, float b1, float b2, float b3) {
    const unsigned pa0 = pk2(a0, a1), pa1 = pk2(a2, a3), pb0 = pk2(b0, b1), pb1 = pk2(b2, b3);
    const auto s0 = __builtin_amdgcn_permlane16_swap(pa0, pb0, false, false);
    const auto s1 = __builtin_amdgcn_permlane16_swap(pa1, pb1, false, false);
    return (u32x4){s0[0], s1[0], s0[1], s1[1]};
}

constexpr int GS_SLOT = 32768;
__device__ __forceinline__ int gs_g(int x) { return (0x78 >> (2 * x)) & 3; }
__device__ __forceinline__ int gs_srcchunk(int tid) { return ((tid & 3) ^ gs_g((tid >> 4) & 3)) * 8; }
template <int GRP, class Setup, class Epi>
__device__ __forceinline__ void gemm_stream_grp(LAS unsigned char* lds, int vb, int nvb, int nunits, int K, size_t ksa, size_t ksb, Setup&& setup, Epi&& epi) {
    const int tid = threadIdx.x, wid = __builtin_amdgcn_readfirstlane(tid >> 6), lane = tid & 63, wr = (wid >> 1) & 1, wcol = (wid >> 2) * 128 + (wid & 1) * 64, fr = lane & 15, fq = lane >> 4;
    const int xb = vb & 7, xslot = vb >> 3, xP = nvb >> 3;
    int xk = 0;
    int u = xb * xP + xslot;
    const int nt = K / 32;
    const bf16_t* abase = nullptr; const bf16_t* bbase = nullptr; unsigned ao[4] = {0u, 0u, 0u, 0u}, bo[4] = {0u, 0u, 0u, 0u};
    if (GRP == 0) { setup(u, 0, abase, bbase, ao, bo); setup(u, 64, abase, bbase, ao + 2, bo + 2); }
    const unsigned ldsw = (unsigned)wid * 1024u;
#define GS_STAGE(pa, pb, kt, slot) do { LAS unsigned char* s_ = lds + (slot) * GS_SLOT + ldsw; \
        const char* ab_ = (const char*)(abase + (size_t)(kt) * ksa); const char* bb_ = (const char*)(bbase + (size_t)(kt) * ksb); \
        _Pragma("unroll") for (int i_ = 0; i_ < 4; ++i_) __builtin_amdgcn_global_load_lds((const unsigned*)(ab_ + ao[i_]), (LAS unsigned*)(s_ + (i_ >> 1) * 4096 + (i_ & 1) * 8192), 16, 0, 0); \
        _Pragma("unroll") for (int i_ = 0; i_ < 4; ++i_) __builtin_amdgcn_global_load_lds((const unsigned*)(bb_ + bo[i_]), (LAS unsigned*)(s_ + 16384 + (i_ >> 1) * 4096 + (i_ & 1) * 8192), 16, 0, 0); } while (0)
#define GS_BARRIER() do { __builtin_amdgcn_sched_barrier(0); __builtin_amdgcn_s_barrier(); __builtin_amdgcn_sched_barrier(0); asm volatile("" ::: "memory"); } while (0)
#define GS_STAGE_NEXT(t_) do { if ((t_) + 2 < nt) GS_STAGE(ap, bp, (t_) + 2, ws); else if (has_next) { if ((t_) + 2 == nt) { setup(un, 0, abase, bbase, ao, bo); setup(un, 64, abase, bbase, ao + 2, bo + 2); } GS_STAGE(ap, bp, (t_) + 2 - nt, ws); } } while (0)
#define GS_READ() do { \
        _Pragma("unroll") for (int m = 0; m < 8; ++m) af[m] = *(const LAS bf16x8*)(sl + aoff + m * 1024); \
        _Pragma("unroll") for (int n = 0; n < 4; ++n) bfr[n] = *(const LAS bf16x8*)(sl + boff + n * 1024); } while (0)
#define GS_MFMA() do { \
        _Pragma("unroll") for (int m = 0; m < 8; ++m) \
        _Pragma("unroll") for (int n = 0; n < 4; ++n) acc[m][n] = MFMA16(bfr[n], af[m], acc[m][n]); } while (0)
      \

#define GS_MFMA_RD() do { \
        _Pragma("unroll") for (int m = 0; m < 8; ++m) { \
            _Pragma("unroll") for (int n = 0; n < 4; ++n) acc[m][n] = MFMA16(bfr[n], af[m], acc[m][n]); \
            af[m] = *(const LAS bf16x8*)(sl + aoff + m * 1024); } \
        _Pragma("unroll") for (int n = 0; n < 4; ++n) bfr[n] = *(const LAS bf16x8*)(sl + boff + n * 1024); } while (0)
    if (GRP == 0) { GS_STAGE(ap, bp, 0, 0); __builtin_amdgcn_sched_barrier(0); GS_STAGE(ap, bp, 1, 1); __builtin_amdgcn_sched_barrier(0); }
    int rs = 0;
    const int swc = (fq ^ gs_g(fr >> 2)) * 16;
    const int aoff = (wr * 128 + fr) * 64 + swc, boff = 16384 + (wcol + fr) * 64 + swc;
    f32x4 acc[8][4];
    bf16x8 af[8], bfr[4];
    if (GRP == 1) {
#pragma unroll
        for (int m = 0; m < 8; ++m) af[m] = (bf16x8)(0);
#pragma unroll
        for (int n = 0; n < 4; ++n) bfr[n] = (bf16x8)(0);
    }
    int upend = u; bool pend = false, have_cur = true;
    for (;;) {
        int un = u; bool has_next = false;
        if (have_cur) { un = ((xk + 1) * 8 + xb) * xP + xslot; has_next = un < nunits; }
        {
            const int t = 0;
            if (!have_cur || GRP == 1) asm volatile("s_waitcnt vmcnt(0) lgkmcnt(0)" ::: "memory");
            else asm volatile("s_waitcnt vmcnt(8) lgkmcnt(0)" ::: "memory");
            GS_BARRIER();
            const int ws = (rs + 2) & 3;
            const LAS unsigned char* sl = lds + rs * GS_SLOT;
            if (GRP == 1) GS_MFMA();
            if (pend) { asm volatile("s_waitcnt vmcnt(0)" ::: "memory"); epi(upend, acc); }
            if (!have_cur) break;
#pragma unroll
            for (int m = 0; m < 8; ++m)
#pragma unroll
                for (int n = 0; n < 4; ++n) acc[m][n] = (f32x4){0.f, 0.f, 0.f, 0.f};
            if (GRP == 0) { GS_READ(); __builtin_amdgcn_sched_barrier(0); GS_STAGE_NEXT(t); }
            __builtin_amdgcn_sched_barrier(0);
            if (GRP == 0) GS_MFMA();
            else { GS_READ(); }
            rs = (rs + 1) & 3;
        }
#pragma clang loop unroll(disable)
        for (int t = 1; t < nt; ++t) {
            if (GRP == 1) asm volatile("s_waitcnt lgkmcnt(0)" ::: "memory");
            else if (!has_next && t == nt - 1) asm volatile("s_waitcnt vmcnt(0) lgkmcnt(0)" ::: "memory");
            else if (pend && t <= 1) asm volatile("s_waitcnt lgkmcnt(0)" ::: "memory");
            else asm volatile("s_waitcnt vmcnt(8) lgkmcnt(0)" ::: "memory");
            GS_BARRIER();
            const int ws = (rs + 2) & 3;
            const LAS unsigned char* sl = lds + rs * GS_SLOT;
            if (GRP == 1) GS_MFMA_RD();
            if (GRP == 0) { GS_READ(); __builtin_amdgcn_sched_barrier(0); GS_STAGE_NEXT(t); }
            __builtin_amdgcn_sched_barrier(0);
            if (GRP == 0) GS_MFMA();
            rs = (rs + 1) & 3;
        }
        pend = true; upend = u;
        if (has_next) { u = un; ++xk; }
        else have_cur = false;
    }
#undef GS_STAGE
#undef GS_STAGE_NEXT
#undef GS_BARRIER
#undef GS_READ
#undef GS_MFMA
#undef GS_MFMA_RD
}
template <class Setup, class Epi>
__device__ __forceinline__ void gemm_stream(LAS unsigned char* lds, int vb, int nvb, int nunits, int K, size_t ksa, size_t ksb, Setup&& setup, Epi&& epi) {
    lds = opaque_lds_s(lds);
    const int grp = __builtin_amdgcn_readfirstlane((int)(threadIdx.x >> 8));
    if ((vb & 7) * (nvb >> 3) + (vb >> 3) < nunits && (vb >> 3) < (nvb >> 3)) {
        if (grp == 0) gemm_stream_grp<0>(lds, vb, nvb, nunits, K, ksa, ksb, setup, epi);
        else gemm_stream_grp<1>(lds, vb, nvb, nunits, K, ksa, ksb, setup, epi);
    }
    asm volatile("s_waitcnt vmcnt(0) lgkmcnt(0)" ::: "memory"); __builtin_amdgcn_s_barrier(); asm volatile("" ::: "memory");
}

__device__ __forceinline__ void tile_decode(int L, int MT, int NT, int& mt, int& nt) {
    const int R = L / (8 * NT), rem = L - R * 8 * NT; const int mrows = (MT - 8 * R) < 8 ? (MT - 8 * R) : 8;
    nt = rem / mrows; mt = 8 * R + (rem - nt * mrows);
}

#define GEMM_IDS const int tid = threadIdx.x, wid = __builtin_amdgcn_readfirstlane(tid >> 6), lane = tid & 63, wr = (wid >> 1) & 1, wcol = (wid >> 2) * 128 + (wid & 1) * 64, fr = lane & 15, fq = lane >> 4
constexpr int INP_XA = 112;
template <int PARTB>
__device__ __forceinline__ void inproj_unit(int u, int& mt, int& nt) {
    constexpr int MT = NROWS / 256;
    if (PARTB == 0) { if (u < MT * 5) tile_decode(u, MT, 5, mt, nt); else { mt = u - MT * 5; nt = 5; } }
    else { if (u < MT - INP_XA) { mt = INP_XA + u; nt = 5; } else { tile_decode(u - (MT - INP_XA), MT, 7, mt, nt); nt += 6; } }
}
template <int PARTB>
__device__ __forceinline__ void phase_inproj(const Params& p, int l, LAS unsigned char* lds, int vb, int nvb) {
    GEMM_IDS;
    const bf16_t* H = (const bf16_t*)(p.ws + WS_RA);
    const bf16_t* W = (const bf16_t*)(p.ws + WS_WIN) + (size_t)l * NPAD * D;
    bf16_t* P1 = (bf16_t*)(p.ws + WS_RB); bf16_t* P2 = (bf16_t*)((unsigned char*)p.out);
    constexpr int MT = NROWS / 256;
    gemm_stream(lds, vb, nvb, PARTB ? (MT - INP_XA) + MT * 7 : MT * 5 + INP_XA, D, (size_t)NROWS * 32, (size_t)NPAD * 32,
        [&](int u, int rofs, const bf16_t*& abase, const bf16_t*& bbase, unsigned* ao, unsigned* bo) { int mt, nt; inproj_unit<PARTB>(u, mt, nt);
            abase = H + (size_t)mt * 256 * 32; bbase = W + (size_t)nt * 256 * 32;
#pragma unroll
            for (int i = 0; i < 2; ++i) ao[i] = bo[i] = (unsigned)((((tid >> 2) + rofs + 128 * i) * 32 + gs_srcchunk(tid)) * 2); },
        [&](int u, f32x4 (&acc)[8][4]) { int mt, nt; inproj_unit<PARTB>(u, mt, nt);
#pragma unroll
            for (int m = 0; m < 8; ++m) {
                const size_t row = (size_t)mt * 256 + wr * 128 + m * 16 + fr;
#pragma unroll
                for (int n = 0; n < 4; n += 2) {
                    const int col = nt * 256 + wcol + n * 16 + PAIR16_COL(fq);
                    const u32x4 w = pack_pair16(acc[m][n][0], acc[m][n][1], acc[m][n][2], acc[m][n][3], acc[m][n + 1][0], acc[m][n + 1][1], acc[m][n + 1][2], acc[m][n + 1][3]);
                    if (col < 1152) *(u32x4*)(P2 + row * P2_LD + col) = w;
                    else if (col < 1176) { bf16_t* d = P1 + row * P1_LD + C_AR + (col - 1152); *(u32x2*)d = (u32x2){w[0], w[1]}; *(u32x2*)(d + 4) = (u32x2){w[2], w[3]}; }
                    else if (col >= 1280 && col + 8 <= 3212) *(u32x4*)(P1 + row * P1_LD + (col - 1280)) = w;
                    else if (col >= 1280 && col < 3212) *(u32x2*)(P1 + row * P1_LD + (col - 1280)) = (u32x2){w[0], w[1]};
                }
            } });
}

__device__ __forceinline__ void phase_outproj(const Params& p, int l, LAS unsigned char* lds) {
    GEMM_IDS;
    const bf16_t* MIX = (const bf16_t*)(p.ws + WS_RD);
    const bf16_t* W = (const bf16_t*)(p.ws + WS_WOUT) + (size_t)l * D * D;
    const float* MOD = (const float*)(p.ws + WS_MOD) + (size_t)l * 3 * 6144;
    bf16_t* XB = (bf16_t*)(p.ws + WS_XB);
    constexpr int MT = NLAT / 256;
    gemm_stream(lds, blockIdx.x, gridDim.x, MT * 4, D, (size_t)NROWS * 32, (size_t)D * 32,
        [&](int u, int rofs, const bf16_t*& abase, const bf16_t*& bbase, unsigned* ao, unsigned* bo) { int mt, nt; tile_decode(u, MT, 4, mt, nt);
            abase = MIX + (size_t)mt * 256 * 32; bbase = W + (size_t)nt * 256 * 32;
#pragma unroll
            for (int i = 0; i < 2; ++i) ao[i] = bo[i] = (unsigned)((((tid >> 2) + rofs + 128 * i) * 32 + gs_srcchunk(tid)) * 2); },
        [&](int u, f32x4 (&acc)[8][4]) { int mt, nt; tile_decode(u, MT, 4, mt, nt);
            const int row_t0 = mt * 256;
            const float* gate = MOD + (size_t)row_mset(row_t0) * 6144 + 2 * D;
#pragma unroll
            for (int m = 0; m < 8; ++m) {
                const int row = row_t0 + wr * 128 + m * 16 + fr;
                const float* src = row < NLAT ? p.x + (size_t)row * D : p.ctx + (size_t)(row - NLAT) * D;
                bf16_t* xb = XB + (size_t)row * D;
                f32x4 o[4];
#pragma unroll
                for (int n = 0; n < 4; ++n) {
                    const int col = nt * 256 + wcol + n * 16 + 4 * fq;
                    const f32x4 g = *(const f32x4*)(gate + col);
                    f32x4 xs;
                    if (l == 0) xs = *(const f32x4*)(src + col);
                    else { const u32x2 w = *(const u32x2*)(xb + col); xs[0] = __uint_as_float(w.x << 16); xs[1] = __uint_as_float(w.x & 0xffff0000u); xs[2] = __uint_as_float(w.y << 16); xs[3] = __uint_as_float(w.y & 0xffff0000u); }
                    o[n][0] = xs[0] + g[0] * acc[m][n][0]; o[n][1] = xs[1] + g[1] * acc[m][n][1]; o[n][2] = xs[2] + g[2] * acc[m][n][2]; o[n][3] = xs[3] + g[3] * acc[m][n][3];
                }
#pragma unroll
                for (int n = 0; n < 4; n += 2)
                    *(u32x4*)(xb + nt * 256 + wcol + n * 16 + PAIR16_COL(fq)) = pack_pair16(o[n][0], o[n][1], o[n][2], o[n][3], o[n + 1][0], o[n + 1][1], o[n + 1][2], o[n + 1][3]);
            } });
    if (l == 0) {
        float* PART = (float*)((unsigned char*)p.out + PART_OFF);
        gemm_stream(lds, blockIdx.x, gridDim.x, 8 * OP_KS, D / OP_KS, (size_t)NROWS * 32, (size_t)D * 32,
            [&](int u, int rofs, const bf16_t*& abase, const bf16_t*& bbase, unsigned* ao, unsigned* bo) { const int ks = u & (OP_KS - 1), tl = u / OP_KS, mt = MT + (tl >> 2), nt = tl & 3;
                abase = MIX + (size_t)ks * (D / OP_KS / 32) * NROWS * 32 + (size_t)mt * 256 * 32; bbase = W + (size_t)ks * (D / OP_KS / 32) * D * 32 + (size_t)nt * 256 * 32;
#pragma unroll
                for (int i = 0; i < 2; ++i) ao[i] = bo[i] = (unsigned)((((tid >> 2) + rofs + 128 * i) * 32 + gs_srcchunk(tid)) * 2); },
            [&](int u, f32x4 (&acc)[8][4]) { const int ks = u & (OP_KS - 1), tl = u / OP_KS, mtc = tl >> 2, nt = tl & 3;
#pragma unroll
                for (int m = 0; m < 8; ++m) {
                    float* pr = PART + ((size_t)ks * (NB * TC) + mtc * 256 + wr * 128 + m * 16 + fr) * D + nt * 256 + wcol + 4 * fq;
#pragma unroll
                    for (int n = 0; n < 4; ++n) *(f32x4*)(pr + n * 16) = acc[m][n];
                } });
    }
}

constexpr int ER_LAT = NB * NE * CAP_L, ER_ALL = ER_LAT + NB * NE * CAP_C;
constexpr size_t W1T_BYTES = (size_t)NE * D * D * 2;
constexpr size_t W2T_OFF = (size_t)96 << 20;
static_assert(PART_OFF + (size_t)OP_KS * NB * TC * D * 4 <= W2T_OFF && W2T_OFF + (size_t)NE * D * FF * 2 <= (size_t)NLAT * D * 4, "W2T fits the d_out tail");
__device__ __forceinline__ void exp_unit(int u, int& g, int& nt, int& er0, int& mvalid) {
    if (u < 1024) { g = u >> 5; nt = (u >> 3) & 3; er0 = g * CAP_L + (u & 7) * 256; mvalid = 256; }
    else { const int v = u - 1024; g = v >> 2; nt = v & 3; er0 = ER_LAT + g * CAP_C; mvalid = CAP_C; }
}

__device__ __forceinline__ void phase_exp1(const Params& p, int l, LAS unsigned char* lds) {
    GEMM_IDS;
    const bf16_t* H2 = (const bf16_t*)(p.ws + WS_RA);
    const bf16_t* W1T = (const bf16_t*)((unsigned char*)p.out);
    bf16_t* HID = (bf16_t*)(p.ws + WS_RB);
    const int* SELROW = (const int*)(p.ws + WS_SELIDX);
    const int nunits = 1024 + ((l == NL - 1) ? 0 : 128);
    gemm_stream(lds, blockIdx.x, gridDim.x, nunits, D, (size_t)NROWS * 32, (size_t)D * 32,
        [&](int u, int rofs, const bf16_t*& abase, const bf16_t*& bbase, unsigned* ao, unsigned* bo) { int g, nt, er0, mvalid; exp_unit(u, g, nt, er0, mvalid); const int e = g & 15;
            abase = H2; bbase = W1T + (size_t)e * D * D + (size_t)nt * 256 * 32;
#pragma unroll
            for (int i = 0; i < 2; ++i) { const int R = (tid >> 2) + rofs + 128 * i; ao[i] = (unsigned)((SELROW[er0 + (R < mvalid ? R : mvalid - 1)] * 32 + gs_srcchunk(tid)) * 2);
                bo[i] = (unsigned)((R * 32 + gs_srcchunk(tid)) * 2); } },
        [&](int u, f32x4 (&acc)[8][4]) { int g, nt, er0, mvalid; exp_unit(u, g, nt, er0, mvalid);
            const int grp = (nt * 256 + wcol) >> 6;
#pragma unroll
            for (int m = 0; m < 8; ++m) {
                const int r = wr * 128 + m * 16 + fr;
                if (r < mvalid) {
                    float h[2][4];
#pragma unroll
                    for (int n = 0; n < 2; ++n)
#pragma unroll
                        for (int q = 0; q < 4; ++q) h[n][q] = silu_f(acc[m][n][q]) * acc[m][n + 2][q];
                    *(u32x4*)(HID + kb_off((size_t)(er0 + r), grp * 32 + PAIR16_COL(fq), ER_ALL)) = pack_pair16(h[0][0], h[0][1], h[0][2], h[0][3], h[1][0], h[1][1], h[1][2], h[1][3]);
                }
            } });
}

__device__ __forceinline__ void phase_exp2(const Params& p, int l, LAS unsigned char* lds) {
    GEMM_IDS;
    const bf16_t* HID = (const bf16_t*)(p.ws + WS_RB);
    const bf16_t* W2T = (const bf16_t*)((unsigned char*)p.out + W2T_OFF);
    bf16_t* YE = (bf16_t*)(p.ws + WS_RD);
    const float* SELGATE = (const float*)(p.ws + WS_SELGATE);
    const int nunits = 1024 + ((l == NL - 1) ? 0 : 128);
    gemm_stream(lds, blockIdx.x, gridDim.x, nunits, FF, (size_t)ER_ALL * 32, (size_t)D * 32,
        [&](int u, int rofs, const bf16_t*& abase, const bf16_t*& bbase, unsigned* ao, unsigned* bo) { int g, nt, er0, mvalid; exp_unit(u, g, nt, er0, mvalid); const int e = g & 15;
            abase = HID + (size_t)er0 * 32; bbase = W2T + (size_t)e * D * FF + (size_t)nt * 256 * 32;
#pragma unroll
            for (int i = 0; i < 2; ++i) { const int R = (tid >> 2) + rofs + 128 * i; ao[i] = (unsigned)(((R < mvalid ? R : mvalid - 1) * 32 + gs_srcchunk(tid)) * 2);
                bo[i] = (unsigned)((R * 32 + gs_srcchunk(tid)) * 2); } },
        [&](int u, f32x4 (&acc)[8][4]) { int g, nt, er0, mvalid; exp_unit(u, g, nt, er0, mvalid);
#pragma unroll
            for (int m = 0; m < 8; ++m) {
                const int r = wr * 128 + m * 16 + fr;
                if (r < mvalid) {
                    const float gt = SELGATE[er0 + r];
#pragma unroll
                    for (int n = 0; n < 4; n += 2)
                        *(u32x4*)(YE + (size_t)(er0 + r) * D + nt * 256 + wcol + n * 16 + PAIR16_COL(fq)) =
                            pack_pair16(acc[m][n][0] * gt, acc[m][n][1] * gt, acc[m][n][2] * gt, acc[m][n][3] * gt, acc[m][n + 1][0] * gt, acc[m][n + 1][1] * gt, acc[m][n + 1][2] * gt, acc[m][n + 1][3] * gt);
                }
            } });
}

__device__ __forceinline__ void phase_norm2_router(const Params& p, int l, LAS unsigned char* lds) {
    const int tid = LTID, lane = tid & 63, wv = __builtin_amdgcn_readfirstlane(tid >> 6);
    LAS float* RW = (LAS float*)lds;
    if (l == 0) {
        const float* MODg = (const float*)(p.ws + WS_MOD);
        for (int u = VB; u < NROWS / 16; u += NVB) {
            const int row = u * 16 + wv * 4;
            if (row < NLAT) continue;
            const float* g1 = MODg + (size_t)row_mset(row) * 6144 + 2 * D;
            float h[4][16];
            load_rows4(p.ctx + (size_t)(row - NLAT) * D, lane, h);
            const float* PART = (const float*)((const unsigned char*)p.out + PART_OFF) + (size_t)(row - NLAT) * D;
#pragma clang loop unroll(disable)
            for (int ks = 0; ks < OP_KS; ++ks) {
#pragma unroll
                for (int j = 0; j < 4; ++j) { const f32x4 g = *(const f32x4*)(g1 + j * 256 + lane * 4);
#pragma unroll
                    for (int r = 0; r < 4; ++r) { const f32x4 t = *(const f32x4*)(PART + ((size_t)ks * (NB * TC) + r) * D + j * 256 + lane * 4);
                        h[r][4 * j] += g[0] * t[0]; h[r][4 * j + 1] += g[1] * t[1]; h[r][4 * j + 2] += g[2] * t[2]; h[r][4 * j + 3] += g[3] * t[3]; } }
                asm volatile("" ::: "memory");
            }
            bf16_t* xw = (bf16_t*)(p.ws + WS_XB) + (size_t)row * D;
#pragma unroll
            for (int r = 0; r < 4; ++r)
#pragma unroll
                for (int j = 0; j < 4; ++j) { u32x2 w; w.x = pk2(h[r][4 * j], h[r][4 * j + 1]); w.y = pk2(h[r][4 * j + 2], h[r][4 * j + 3]); *(u32x2*)(xw + (size_t)r * D + j * 256 + lane * 4) = w; }
        }
    }
    { const float* rw = p.router_w + (size_t)l * D * NE;
      for (int i = tid; i < D * NE / 4; i += NTHR) { const int c = i >> 2, q = i & 3; *(LAS f32x4*)(RW + (((q * 4 + (c & 3)) * 256 + (c >> 2)) * 4)) = *(const f32x4*)(rw + i * 4); }
      __syncthreads(); }
    bf16_t* H2 = (bf16_t*)(p.ws + WS_RA);
    const float* MOD = (const float*)(p.ws + WS_MOD) + (size_t)l * 3 * 6144;
    const bf16_t* XB = (const bf16_t*)(p.ws + WS_XB);
    float* AFF = (float*)(p.ws + WS_AFF);
    const int nrows = (l == NL - 1) ? NLAT : NROWS;
    for (int u = VB; u < nrows / 16; u += NVB) {
        const int row = u * 16 + wv * 4;
        const float* m = MOD + (size_t)row_mset(row) * 6144;
        float h[4][16]; load_rows4_bf16(XB + (size_t)row * D, lane, h);
        norm_mod4(h, p.norm2_g + l * D, m + 3 * D, m + 4 * D, lane);
        store_rows4_bf16(H2, (size_t)row, lane, h);
        float lg[4][16];
#pragma unroll
        for (int r = 0; r < 4; ++r)
#pragma unroll
            for (int e = 0; e < 16; ++e) lg[r][e] = 0.f;
#pragma unroll
        for (int j = 0; j < 16; ++j) {
            const LAS f32x4* wr4 = (const LAS f32x4*)RW + ((j & 3) * 256 + (j >> 2) * 64 + lane);
            const f32x4 w0 = wr4[0], w1 = wr4[1024], w2 = wr4[2048], w3 = wr4[3072];
#pragma unroll
            for (int r = 0; r < 4; ++r)
#pragma unroll
                for (int e = 0; e < 4; ++e) { lg[r][e] += h[r][j] * w0[e]; lg[r][4 + e] += h[r][j] * w1[e]; lg[r][8 + e] += h[r][j] * w2[e]; lg[r][12 + e] += h[r][j] * w3[e]; }
            if ((j & 1) == 1) asm volatile("" ::: "memory");
        }
        float z[4];
#pragma unroll
        for (int r = 0; r < 4; ++r) {
#pragma unroll
            for (int i = 0; i < 8; ++i) { const bool up = lane & 32; const float send = up ? lg[r][i] : lg[r][i + 8]; const float recv = __shfl_xor(send, 32); lg[r][i] = (up ? lg[r][i + 8] : lg[r][i]) + recv; }
#pragma unroll
            for (int i = 0; i < 4; ++i) { const bool up = lane & 16; const float send = up ? lg[r][i] : lg[r][i + 4]; const float recv = __shfl_xor(send, 16); lg[r][i] = (up ? lg[r][i + 4] : lg[r][i]) + recv; }
#pragma unroll
            for (int i = 0; i < 2; ++i) { const bool up = lane & 8; const float send = up ? lg[r][i] : lg[r][i + 2]; const float recv = __shfl_xor(send, 8); lg[r][i] = (up ? lg[r][i + 2] : lg[r][i]) + recv; }
            { const bool up = lane & 4; const float send = up ? lg[r][0] : lg[r][1]; const float recv = __shfl_xor(send, 4); lg[r][0] = (up ? lg[r][1] : lg[r][0]) + recv; }
            float zz = lg[r][0]; zz += __shfl_xor(zz, 2); zz += __shfl_xor(zz, 1); z[r] = zz;
        }
        const int e = ((lane >> 5) & 1) * 8 + ((lane >> 4) & 1) * 4 + ((lane >> 3) & 1) * 2 + ((lane >> 2) & 1);
#pragma unroll
        for (int r = 0; r < 4; ++r) {
            float mx = z[r];
            mx = fmaxf(mx, __shfl_xor(mx, 4)); mx = fmaxf(mx, __shfl_xor(mx, 8)); mx = fmaxf(mx, __shfl_xor(mx, 16)); mx = fmaxf(mx, __shfl_xor(mx, 32));
            const float ex = __expf(z[r] - mx);
            float sm = ex; sm += __shfl_xor(sm, 4); sm += __shfl_xor(sm, 8); sm += __shfl_xor(sm, 16); sm += __shfl_xor(sm, 32);
            const float a = ex / sm;
            if ((lane & 3) == 0) {
                const int rr = row + r;
                if (rr < NLAT) { const int b = rr / T, t = rr % T; AFF[((size_t)b * NE + e) * T + t] = a; }
                else { const int q = rr - NLAT, b = q / TC, t = q % TC; AFF[(size_t)NB * NE * T + ((size_t)b * NE + e) * TC + t] = a; }
            }
        }
    }
    __syncthreads();
}

__device__ __forceinline__ int block_excl_scan(int v, LAS int* sc  , int& total) {
    const int lane = LTID & 63, wv = __builtin_amdgcn_readfirstlane(LTID >> 6);
    int x = v;
#pragma unroll
    for (int o = 1; o < 64; o <<= 1) { const int y = __shfl_up(x, o); if (lane >= o) x += y; }
    __syncthreads();
    if (lane == 63) sc[wv] = x;
    __syncthreads();
    int base = 0, tot = 0;
#pragma unroll
    for (int w = 0; w < 4; ++w) { const int s = sc[w]; if (w < wv) base += s; tot += s; }
    total = tot;
    return base + x - v;
}

__device__ __forceinline__ void conv_weight_tile(const Params& p, int l, int v, LAS unsigned char* lds, int tid) {
    bf16_t* W1T = (bf16_t*)((unsigned char*)p.out); bf16_t* W2T = (bf16_t*)((unsigned char*)p.out + W2T_OFF);
    LAS float* tile = (LAS float*)lds;
    const float* src; size_t sld; bf16_t* dst; int dk0 = 0, dn0 = 0;
    int nrow_map_gate = -1;
    int grp0 = 0;
    if (v < 4096) {
        const int isup = v >> 11, w = v & 2047, e = w >> 7, kt = (w >> 3) & 15, ft = w & 7;
        src = (isup ? p.exp_w_up : p.exp_w_gate) + (((size_t)l * NE + e) * D + kt * 64) * FF + ft * 64; sld = FF;
        dst = W1T + (size_t)e * D * D; dk0 = kt * 64; dn0 = 0; nrow_map_gate = isup; grp0 = ft * 2;
    } else {
        const int w = v - 4096, e = w >> 7, ft = (w >> 4) & 7, nt = w & 15;
        src = p.exp_w_down + (((size_t)l * NE + e) * FF + ft * 64) * D + nt * 64; sld = D;
        dst = W2T + (size_t)e * D * FF; dk0 = ft * 64; dn0 = nt * 64;
    }
    for (int q = tid; q < 1024; q += NTHR) { const int k = q >> 4, n = (q & 15) * 4; const f32x4 v4 = *(const f32x4*)(src + (size_t)k * sld + n);
        tile[k * 65 + n] = v4[0]; tile[k * 65 + n + 1] = v4[1]; tile[k * 65 + n + 2] = v4[2]; tile[k * 65 + n + 3] = v4[3]; }
    __syncthreads();
    { const int n = tid >> 2, k0 = (tid & 3) * 16; u32x4 w0, w1; float f[16];
#pragma unroll
      for (int j = 0; j < 16; ++j) f[j] = tile[(k0 + j) * 65 + n];
      w0.x = pk2(f[0], f[1]); w0.y = pk2(f[2], f[3]); w0.z = pk2(f[4], f[5]); w0.w = pk2(f[6], f[7]);
      w1.x = pk2(f[8], f[9]); w1.y = pk2(f[10], f[11]); w1.z = pk2(f[12], f[13]); w1.w = pk2(f[14], f[15]);
      size_t drow;
      if (nrow_map_gate < 0) drow = (size_t)(dn0 + n);
      else drow = (size_t)(grp0 + (n >> 5)) * 64 + nrow_map_gate * 32 + (n & 31);
      bf16_t* d = dst + kb_off(drow, dk0 + k0, D);
      *(u32x4*)d = w0; *(u32x4*)(d + 8) = w1; }
    __syncthreads();
}
constexpr int TK_CONV_UNITS = 4096;
constexpr int SIDE_CONV_UNITS = 2048;
__device__ __forceinline__ void phase_topk_conv(const Params& p, int l, LAS unsigned char* lds) {
    const int tid = LTID;
    const int n_tk = 64;
    const float* AFF = (const float*)(p.ws + WS_AFF);
    int* SELROW = (int*)(p.ws + WS_SELIDX); float* SELGATE = (float*)(p.ws + WS_SELGATE); int* SLOT = (int*)(p.ws + WS_SLOT);
    if ((int)blockIdx.x * 2 < n_tk) {
        { const int u = VB;
            const int isctx = u & 1, g = u >> 1, b = g >> 4, e = g & 15;
            const int N = isctx ? ((l == NL - 1) ? 0 : TC) : T, KSEL = N / 8;
            const float* src = isctx ? AFF + (size_t)NB * NE * T + (size_t)g * TC : AFF + (size_t)g * T;
            const int rowbase = isctx ? NLAT + b * TC : b * T;
            const int er0 = isctx ? ER_LAT + g * CAP_C : g * CAP_L;
#define VP(n) ((n) + ((n) >> 6))
            LAS unsigned* VAL = (LAS unsigned*)lds;
            LAS int* HIST = (LAS int*)(lds + 66560);
            LAS int* SC = HIST + 1024;
            const int wvl = tid >> 6;
            for (int i = tid; i < N; i += NTHR) VAL[VP(i)] = __float_as_uint(src[i]);
            unsigned prefix = 0u, pmask = 0u; int kk = KSEL;
            for (int shift = 24; shift >= 0; shift -= 8) {
                HIST[tid] = 0; HIST[256 + tid] = 0; HIST[512 + tid] = 0; HIST[768 + tid] = 0;
                __syncthreads();
                for (int i = tid; i < N; i += NTHR) { const unsigned v = VAL[VP(i)]; if ((v & pmask) == prefix) atomicAdd((int*)&HIST[wvl * 256 + ((v >> shift) & 255u)], 1); }
                __syncthreads();
                const int hv = HIST[255 - tid] + HIST[256 + 255 - tid] + HIST[512 + 255 - tid] + HIST[768 + 255 - tid]; int tot;
                const int above = block_excl_scan(hv, SC, tot);
                if (above < kk && kk <= above + hv) { SC[8] = 255 - tid; SC[9] = kk - above; }
                __syncthreads();
                prefix |= ((unsigned)SC[8]) << shift; pmask |= 255u << shift; kk = SC[9];
                __syncthreads();
            }
            const int per = N / NTHR, i0 = tid * per;
            int ngt = 0, neq = 0;
            for (int i = 0; i < per; ++i) { const unsigned v = VAL[VP(i0 + i)]; ngt += v > prefix; neq += v == prefix; }
            int tot;
            const int eqbase = block_excl_scan(neq, SC, tot);
            int ntake = ngt; { int er = eqbase; for (int i = 0; i < per; ++i) { const unsigned v = VAL[VP(i0 + i)]; if (v == prefix) { ntake += er < kk; ++er; } } }
            int pos = block_excl_scan(ntake, SC, tot);
            { int er = eqbase;
              for (int i = 0; i < per; ++i) { const unsigned v = VAL[VP(i0 + i)]; bool take = v > prefix;
                  if (v == prefix) { take = er < kk; ++er; }
                  const int row = rowbase + i0 + i;
                  int sl = -1;
                  if (take) { SELROW[er0 + pos] = row; SELGATE[er0 + pos] = __uint_as_float(v); sl = er0 + pos; ++pos; }
                  VAL[VP(i0 + i)] = (unsigned)sl; } }
            __syncthreads();
            for (int i = tid; i < N; i += NTHR) SLOT[(size_t)e * NROWS + rowbase + i] = (int)VAL[VP(i)];
#undef VP
            __syncthreads();
        }
    }
    const int nvc = NVB - n_tk, vbc = VB - n_tk;
    if (vbc >= 0)
    for (int it = 0; it < (TK_CONV_UNITS + nvc - 1) / nvc; ++it) { int v = vbc + it * nvc; if (v >= TK_CONV_UNITS) v = TK_CONV_UNITS - 1; conv_weight_tile(p, l, v, lds, tid); }
}

__device__ __forceinline__ void phase_combine(const Params& p, int l) {
    const int lane = LTID & 63, wv = __builtin_amdgcn_readfirstlane(LTID >> 6);
    const bf16_t* YE = (const bf16_t*)(p.ws + WS_RD);
    const int* SLOT = (const int*)(p.ws + WS_SLOT);
    const float* MOD = (const float*)(p.ws + WS_MOD);
    bf16_t* XB = (bf16_t*)(p.ws + WS_XB);
    bf16_t* H = (bf16_t*)(p.ws + WS_RA);
    const bool last = (l == NL - 1);
    const int nrows = last ? NLAT : NROWS;
    for (int u = VB; u < nrows / 16; u += NVB) {
        const int row = u * 16 + wv * 4;
        bf16_t* xr = XB + (size_t)row * D;
        const int ms = row_mset(row);
        const float* m = MOD + ((size_t)l * 3 + ms) * 6144;
        const int myslot = SLOT[(size_t)(lane & 15) * NROWS + row + (lane >> 4)];
        float v[4][16], acc[4][16];
        load_rows4_bf16(xr, lane, v);
        const unsigned long long act = __ballot(myslot >= 0);
#pragma unroll
        for (int r = 0; r < 4; ++r)
#pragma unroll
            for (int j = 0; j < 16; ++j) acc[r][j] = 0.f;
        unsigned mk0 = (unsigned)(act & 0xffffull), mk1 = (unsigned)((act >> 16) & 0xffffull), mk2 = (unsigned)((act >> 32) & 0xffffull), mk3 = (unsigned)((act >> 48) & 0xffffull);
        while (mk0 | mk1 | mk2 | mk3) {
            int sl[4]; float wt[4];
#define CB_TAKE(r, mk) do { \
                const int e0_ = mk ? (__ffs(mk) - 1) : 0; wt[r] = mk ? 1.f : 0.f; mk &= mk - 1; \
                const int a0_ = __shfl(myslot, 16 * r + e0_); sl[r] = (wt[r] != 0.f) ? a0_ : 0; } while (0)
            CB_TAKE(0, mk0); CB_TAKE(1, mk1); CB_TAKE(2, mk2); CB_TAKE(3, mk3);
#undef CB_TAKE
            u32x2 ya[4][4];
#pragma unroll
            for (int r = 0; r < 4; ++r) { const bf16_t* yr = YE + (size_t)sl[r] * D;
#pragma unroll
                for (int j = 0; j < 4; ++j) ya[r][j] = *(const u32x2*)(yr + j * 256 + lane * 4); }
#pragma unroll
            for (int r = 0; r < 4; ++r) { const float w = wt[r];
#pragma unroll
                for (int j = 0; j < 4; ++j) {
                    acc[r][4 * j] += w * __uint_as_float(ya[r][j].x << 16); acc[r][4 * j + 1] += w * __uint_as_float(ya[r][j].x & 0xffff0000u);
                    acc[r][4 * j + 2] += w * __uint_as_float(ya[r][j].y << 16); acc[r][4 * j + 3] += w * __uint_as_float(ya[r][j].y & 0xffff0000u); } }
        }
#pragma unroll
        for (int j = 0; j < 4; ++j) { const f32x4 g = *(const f32x4*)(m + 5 * D + j * 256 + lane * 4);
#pragma unroll
            for (int e = 0; e < 4; ++e)
#pragma unroll
                for (int r = 0; r < 4; ++r) v[r][4 * j + e] += g[e] * acc[r][4 * j + e]; }
        if (!last) {
#pragma unroll
            for (int r = 0; r < 4; ++r)
#pragma unroll
                for (int j = 0; j < 4; ++j) { u32x2 w; w.x = pk2(v[r][4 * j], v[r][4 * j + 1]); w.y = pk2(v[r][4 * j + 2], v[r][4 * j + 3]); *(u32x2*)(xr + (size_t)r * D + j * 256 + lane * 4) = w; }
            const float* m2 = MOD + ((size_t)(l + 1) * 3 + ms) * 6144;
            norm_mod4(v, p.norm1_g + (l + 1) * D, m2, m2 + D, lane);
            store_rows4_bf16(H, (size_t)row, lane, v);
        } else {
            float ss[4];
#pragma unroll
            for (int r = 0; r < 4; ++r) { float t = 0.f;
#pragma unroll
                for (int j = 0; j < 16; ++j) t += v[r][j] * v[r][j];
                ss[r] = t; }
#pragma unroll
            for (int o = 32; o > 0; o >>= 1) {
#pragma unroll
                for (int r = 0; r < 4; ++r) ss[r] += __shfl_xor(ss[r], o); }
#pragma unroll
            for (int j = 0; j < 4; ++j) { const f32x4 g = *(const f32x4*)(p.final_norm_g + j * 256 + lane * 4);
#pragma unroll
                for (int r = 0; r < 4; ++r) { const float rstd = rsqrtf(ss[r] * (1.f / D) + EPS);
                    *(f32x4*)(p.out + (size_t)(row + r) * D + j * 256 + lane * 4) = (f32x4){v[r][4 * j] * rstd * g[0], v[r][4 * j + 1] * rstd * g[1], v[r][4 * j + 2] * rstd * g[2], v[r][4 * j + 3] * rstd * g[3]}; } }
        }
    }
}

__device__ __forceinline__ void unpack4(const u32x2 w, float (&f)[4]) {
    f[0] = __uint_as_float(w.x << 16); f[1] = __uint_as_float(w.x & 0xffff0000u); f[2] = __uint_as_float(w.y << 16); f[3] = __uint_as_float(w.y & 0xffff0000u);
}
__device__ __forceinline__ void phase_post_tok(const Params& p, int l) {
    const int lane = LTID & 63, wv = __builtin_amdgcn_readfirstlane(LTID >> 6);
    const bf16_t* P1 = (const bf16_t*)(p.ws + WS_RB);
    const bf16_t* O = (const bf16_t*)((unsigned char*)p.out);
    bf16_t* MIX = (bf16_t*)(p.ws + WS_RD);
    const float* SSQP = (const float*)(p.ws + WS_SSQP);
    const bf16_t* YS = (const bf16_t*)((unsigned char*)p.out) + (size_t)2 * NROWS * 384;
    const bool last = (l == NL - 1);
    const int nrows = last ? NLAT : NROWS;
    for (int u = VB; u < nrows / 16; u += NVB) {
        const int row = u * 16 + wv * 4;
        int base, t0, N;
        if (row < NLAT) { base = (row / T) * T; t0 = row % T; N = T; } else { const int q = row - NLAT; base = NLAT + (q / TC) * TC; t0 = q % TC; N = TC; }
        const int half = 1 << (lane >> 4);
        u32x2 src[20];
#pragma unroll
        for (int k = 0; k < 20; ++k) { const int tt = t0 - 8 + k;
            src[k] = (tt >= 0 && tt < N && (k >= 8 - half) && (k < 11 + half + 1)) ? *(const u32x2*)(P1 + (size_t)(base + tt) * P1_LD + C_U + lane * 4) : (u32x2){0u, 0u}; }
        const float* ngs = p.ssd_norm_g + l * 384;
        const f32x4 g0 = *(const f32x4*)(ngs + lane * 4), g1 = *(const f32x4*)(ngs + 256 + (lane & 31) * 4);
        float ss4[4]; u32x2 w0[4], w1[4];
#pragma unroll
        for (int r = 0; r < 4; ++r) { ss4[r] = lane < 24 ? SSQP[(size_t)(row + r) * 24 + lane] : 0.f;
            w0[r] = *(const u32x2*)(YS + (size_t)(row + r) * 384 + lane * 4);
            w1[r] = *(const u32x2*)(YS + (size_t)(row + r) * 384 + 256 + (lane & 31) * 4); }
        const f32x4 ng = *(const f32x4*)(p.gdn_norm_g + l * 64 + (lane & 15) * 4);
        u32x2 of0[4], ob0[4], gt0[4], of1[4], ob1[4], gt1[4];
        {
            const int c1 = 256 + (lane & 31) * 4;
            const int h0 = lane >> 4, h1 = 4 + ((lane & 31) >> 4), vv = (lane & 15) * 4;
#pragma unroll
            for (int r = 0; r < 4; ++r) { const size_t rr = (size_t)(row + r);
                size_t ocl;
                { const int rw = row + r;
                  if (rw < NLAT) { const int bb = rw / T, tt = rw % T; const int pp = (tt & 63) * 256 + (tt >> 6); ocl = (size_t)((bb * 256 + (pp >> 6)) * 6) * 4096 + (pp & 63) * 64; }
                  else { const int q = rw - NLAT; ocl = (size_t)((512 + (q >> 6)) * 6) * 4096 + (q & 63) * 64; } }
                of0[r] = *(const u32x2*)(O + ocl + h0 * 4096 + vv); ob0[r] = *(const u32x2*)(O + (size_t)NCHUNK * 6 * 4096 + ocl + h0 * 4096 + vv);
                gt0[r] = *(const u32x2*)(P1 + rr * P1_LD + C_GATE + lane * 4);
                of1[r] = *(const u32x2*)(O + ocl + h1 * 4096 + vv); ob1[r] = *(const u32x2*)(O + (size_t)NCHUNK * 6 * 4096 + ocl + h1 * 4096 + vv);
                gt1[r] = *(const u32x2*)(P1 + rr * P1_LD + C_GATE + c1); }
        }
        {
            float sum[4][4];
#pragma unroll
            for (int r = 0; r < 4; ++r)
#pragma unroll
                for (int e = 0; e < 4; ++e) sum[r][e] = 0.f;
#pragma unroll
            for (int k = 0; k < 20; ++k) { float f[4]; unpack4(src[k], f);
#pragma unroll
                for (int r = 0; r < 4; ++r) { const int d = k - 8 - r;
                    if (d >= -8 && d < 8) { const bool in = (d >= -half) && (d < half);
#pragma unroll
                        for (int e = 0; e < 4; ++e) sum[r][e] += in ? f[e] : 0.f; } } }
#pragma unroll
            for (int r = 0; r < 4; ++r) { const int t = t0 + r;
                const int lo = max(t - half, 0), hi = min(t + half, N);
                const float inv = 1.f / (float)(hi - lo);
                float c[4]; unpack4(src[8 + r], c);
                u32x2 o; o.x = pk2(sum[r][0] * inv - c[0], sum[r][1] * inv - c[1]); o.y = pk2(sum[r][2] * inv - c[2], sum[r][3] * inv - c[3]);
                *(u32x2*)(MIX + kb_off((size_t)(row + r), lane * 4, NROWS)) = o; }
        }
        {
#pragma unroll
            for (int o = 32; o > 0; o >>= 1) {
#pragma unroll
                for (int r = 0; r < 4; ++r) ss4[r] += __shfl_xor(ss4[r], o); }
#pragma unroll
            for (int r = 0; r < 4; ++r) { const float rstd = rsqrtf(ss4[r] * (1.f / 384.f) + EPS);
                float f[4]; unpack4(w0[r], f);
                u32x2 o; o.x = pk2(f[0] * rstd * g0[0], f[1] * rstd * g0[1]); o.y = pk2(f[2] * rstd * g0[2], f[3] * rstd * g0[3]);
                *(u32x2*)(MIX + kb_off((size_t)(row + r), 256 + lane * 4, NROWS)) = o;
                unpack4(w1[r], f);
                o.x = pk2(f[0] * rstd * g1[0], f[1] * rstd * g1[1]); o.y = pk2(f[2] * rstd * g1[2], f[3] * rstd * g1[3]);
                if (lane < 32) *(u32x2*)(MIX + kb_off((size_t)(row + r), 512 + lane * 4, NROWS)) = o; }
        }
        {
#pragma unroll
            for (int r = 0; r < 4; ++r) { const size_t rr = (size_t)(row + r);
                float a[4], b[4], g[4], o[4];
                unpack4(of0[r], a); unpack4(ob0[r], b); unpack4(gt0[r], g);
                float ss = 0.f;
#pragma unroll
                for (int e = 0; e < 4; ++e) { o[e] = a[e] + b[e]; ss += o[e] * o[e]; }
                ss += __shfl_xor(ss, 1); ss += __shfl_xor(ss, 2); ss += __shfl_xor(ss, 4); ss += __shfl_xor(ss, 8);
                float rs = rsqrtf(ss * (1.f / 64.f) + EPS);
                u32x2 w; w.x = pk2(o[0] * rs * ng[0] * silu_f(g[0]), o[1] * rs * ng[1] * silu_f(g[1])); w.y = pk2(o[2] * rs * ng[2] * silu_f(g[2]), o[3] * rs * ng[3] * silu_f(g[3]));
                *(u32x2*)(MIX + kb_off(rr, 640 + lane * 4, NROWS)) = w;
                unpack4(of1[r], a); unpack4(ob1[r], b); unpack4(gt1[r], g);
                ss = 0.f;
#pragma unroll
                for (int e = 0; e < 4; ++e) { o[e] = a[e] + b[e]; ss += o[e] * o[e]; }
                ss += __shfl_xor(ss, 1); ss += __shfl_xor(ss, 2); ss += __shfl_xor(ss, 4); ss += __shfl_xor(ss, 8);
                rs = rsqrtf(ss * (1.f / 64.f) + EPS);
                w.x = pk2(o[0] * rs * ng[0] * silu_f(g[0]), o[1] * rs * ng[1] * silu_f(g[1])); w.y = pk2(o[2] * rs * ng[2] * silu_f(g[2]), o[3] * rs * ng[3] * silu_f(g[3]));
                if (lane < 32) *(u32x2*)(MIX + kb_off(rr, 896 + lane * 4, NROWS)) = w; }
        }
    }
}

template <class F>
__device__ __forceinline__ void conv8_slide(const bf16_t* src, int ld, int row_of_t0  , int row_stride, int tstart, int N,
                                            const float* w, int wld, const float* bias, F&& emit) {
    float wt[5][8], bs[8];
#pragma unroll
    for (int k = 0; k < 5; ++k) { const f32x4 a = *(const f32x4*)(w + (size_t)k * wld), b = *(const f32x4*)(w + (size_t)k * wld + 4);
        wt[k][0] = a[0]; wt[k][1] = a[1]; wt[k][2] = a[2]; wt[k][3] = a[3]; wt[k][4] = b[0]; wt[k][5] = b[1]; wt[k][6] = b[2]; wt[k][7] = b[3]; }
    if (bias) { const f32x4 a = *(const f32x4*)bias, b = *(const f32x4*)(bias + 4); bs[0] = a[0]; bs[1] = a[1]; bs[2] = a[2]; bs[3] = a[3]; bs[4] = b[0]; bs[5] = b[1]; bs[6] = b[2]; bs[7] = b[3]; }
    else {
#pragma unroll
        for (int e = 0; e < 8; ++e) bs[e] = 0.f; }
    u32x4 win[12];
#pragma unroll
    for (int i = 0; i < 12; ++i) { const int t = tstart - 2 + i;
        win[i] = (t >= 0 && t < N) ? *(const u32x4*)(src + (size_t)(row_of_t0 + (i - 2) * row_stride) * ld) : (u32x4){0u, 0u, 0u, 0u}; }
#pragma unroll
    for (int i = 0; i < 8; ++i) {
        float o[8];
#pragma unroll
        for (int e = 0; e < 8; ++e) o[e] = bs[e];
#pragma unroll
        for (int k = 0; k < 5; ++k) { float f[8]; unpack8(win[i + k], f);
#pragma unroll
            for (int e = 0; e < 8; ++e) o[e] += wt[k][e] * f[e]; }
#pragma unroll
        for (int e = 0; e < 8; ++e) o[e] = silu_f(o[e]);
        emit(i, o);
    }
}

__device__ __forceinline__ float wave_scan_dir(float v, int lane, int dir) {
    float x = v;
    if (dir == 0) {
#pragma unroll
        for (int o = 1; o < 64; o <<= 1) { const float y = __shfl_up(x, o); if (lane >= o) x += y; }
    } else {
#pragma unroll
        for (int o = 1; o < 64; o <<= 1) { const float y = __shfl_down(x, o); if (lane + o < 64) x += y; }
    }
    return x;
}

__device__ __forceinline__ void ssd_chunk_geom(int cid, int& t0, int& N) {
    if (cid < 512) { t0 = (cid & 255) * 64; N = T; } else { t0 = ((cid - 512) & 3) * 64; N = TC; }
}

constexpr int LDT = 72;
__device__ __forceinline__ void ssd_passA_unit(const Params& p, int l, int cid, int g, LAS unsigned char* lds) {
    lds = opaque_lds(lds);
    const int tid = opaque_tid(), lane = tid & 63, wv = __builtin_amdgcn_readfirstlane(tid >> 6), fr = lane & 15, fq = lane >> 4;
    const bf16_t* P1 = (const bf16_t*)(p.ws + WS_RB);
    bf16_t* SS = (bf16_t*)(p.ws + WS_RA);
    float* SSDCD = (float*)(p.ws + WS_SSDCD);
    LAS bf16_t* XT = (LAS bf16_t*)lds;
    LAS bf16_t* BT = XT + 3 * 64 * LDT;
    LAS float* WGT = (LAS float*)(BT + 128 * LDT);
    int t0, N; ssd_chunk_geom(cid, t0, N);
    const int row0 = cid * 64;
    for (int s = wv; s < 6; s += 4) {
        const int hl = s >> 1, dir = s & 1, h = g * 3 + hl;
        const float dtr = bf2f(P1[(size_t)(row0 + lane) * P1_LD + C_DT + dir * 6 + h]);
        const float dt = softplus_f(dtr + p.ssd_dt_bias[(l * 2 + dir) * 6 + h]);
        const float a = -__expf(p.ssd_a_log[(l * 2 + dir) * 6 + h]);
        const float ac = wave_scan_dir(dt * a, lane, dir);
        const float aend = __shfl(ac, dir ? 0 : 63);
        WGT[s * 64 + lane] = __expf(aend - ac) * dt;
        if (lane == 0) SSDCD[((size_t)dir * NCHUNK + cid) * 6 + h] = __expf(aend);
    }
    for (int pass = 0; pass < 2; ++pass) {
        const int vs = pass * 32 + (tid & 31), tg = tid >> 5;
        if (vs < 40) {
            const int isB = vs >= 24;
            const int ch = isB ? (384 + g * 128 + (vs - 24) * 8) : (g * 192 + vs * 8);
            const int ts = t0 + tg * 8;
            conv8_slide(P1 + C_XS + ch, P1_LD, row0 + tg * 8, 1, ts, N, p.ssd_conv_w + (size_t)l * 5 * 896 + ch, 896, p.ssd_conv_b + l * 896 + ch,
                [&](int i, const float (&o)[8]) {
                    const int j = tg * 8 + i;
                    if (isB) { const int n0 = (vs - 24) * 8;
#pragma unroll
                        for (int e = 0; e < 8; ++e) BT[(n0 + e) * LDT + j] = f2bf(o[e]); }
                    else { const int hl = vs >> 3, p0 = (vs & 7) * 8;
#pragma unroll
                        for (int e = 0; e < 8; ++e) XT[(hl * 64 + p0 + e) * LDT + j] = f2bf(o[e]); }
                });
        }
    }
    __syncthreads();
    for (int s = 0; s < 6; ++s) {
        const int hl = s >> 1, dir = s & 1, h = g * 3 + hl;
        bf16x8 bfr[2];
#pragma unroll
        for (int ks = 0; ks < 2; ++ks) {
            const u32x4 raw = *(const LAS u32x4*)(XT + (hl * 64 + wv * 16 + fr) * LDT + ks * 32 + fq * 8);
            float f[8]; unpack8(raw, f);
            const LAS float* wp = WGT + s * 64 + ks * 32 + fq * 8;
            u32x4 o; o.x = pk2(f[0] * wp[0], f[1] * wp[1]); o.y = pk2(f[2] * wp[2], f[3] * wp[3]); o.z = pk2(f[4] * wp[4], f[5] * wp[5]); o.w = pk2(f[6] * wp[6], f[7] * wp[7]);
            bfr[ks] = __builtin_bit_cast(bf16x8, o);
        }
        bf16_t* dst = SS + (((size_t)dir * NCHUNK + cid) * 6 + h) * 8192;
#pragma unroll
        for (int mt = 0; mt < 8; ++mt) {
            f32x4 acc = (f32x4){0.f, 0.f, 0.f, 0.f};
#pragma unroll
            for (int ks = 0; ks < 2; ++ks) acc = MFMA16(ldfrag(BT, LDT, mt * 16, ks * 32, lane), bfr[ks], acc);
            u32x2 w; w.x = pk2(acc[0], acc[1]); w.y = pk2(acc[2], acc[3]);
            *(u32x2*)(dst + (size_t)(wv * 16 + fr) * 128 + mt * 16 + 4 * fq) = w;
        }
    }
    __syncthreads();
}

__device__ __forceinline__ void tri_solve_blk(const LAS float* X, LAS bf16_t* Tm, int lane) {
    const int fr = lane & 15, fq = lane >> 4;
#pragma unroll
    for (int c = 0; c < 9; ++c) *(LAS u32x4*)(Tm + (c * 64 + lane) * 8) = (u32x4){0u, 0u, 0u, 0u};
    asm volatile("s_waitcnt lgkmcnt(0)" ::: "memory");
    {
        const LAS float* Xb = X + (16 * fq) * 64 + 16 * fq;
        float t[16];
#pragma unroll
        for (int r = 0; r < 16; ++r) {
            float acc = (r == fr) ? 1.f : 0.f;
#pragma unroll
            for (int k = 0; k < r; ++k) acc -= Xb[r * 64 + k] * t[k];
            t[r] = acc;
        }
#pragma unroll
        for (int r = 0; r < 16; ++r) Tm[(16 * fq + r) * LDT + 16 * fq + fr] = f2bf(t[r]);
    }
    asm volatile("s_waitcnt lgkmcnt(0)" ::: "memory");
#pragma unroll
    for (int pr = 0; pr < 2; ++pr) {
        const int a = 2 * pr, b = 2 * pr + 1;
        f32x4 x0 = (f32x4){0.f, 0.f, 0.f, 0.f}, x1 = x0; u32x4 tb = (u32x4){0u, 0u, 0u, 0u};
        if (fq < 2) {
            x0 = *(const LAS f32x4*)(X + (16 * b + fr) * 64 + 16 * a + 8 * fq); x1 = *(const LAS f32x4*)(X + (16 * b + fr) * 64 + 16 * a + 8 * fq + 4);
            unsigned tv[8];
#pragma unroll
            for (int e = 0; e < 8; ++e) tv[e] = Tm[(16 * a + 8 * fq + e) * LDT + 16 * a + fr];
            tb.x = tv[0] | (tv[1] << 16); tb.y = tv[2] | (tv[3] << 16); tb.z = tv[4] | (tv[5] << 16); tb.w = tv[6] | (tv[7] << 16);
        }
        u32x4 xa; xa.x = pk2(x0[0], x0[1]); xa.y = pk2(x0[2], x0[3]); xa.z = pk2(x1[0], x1[1]); xa.w = pk2(x1[2], x1[3]);
        const f32x4 m1 = MFMA16(__builtin_bit_cast(bf16x8, xa), __builtin_bit_cast(bf16x8, tb), ((f32x4){0.f, 0.f, 0.f, 0.f}));
        u32x4 bo; bo.x = pk2(m1[0], m1[1]); bo.y = pk2(m1[2], m1[3]); bo.z = 0u; bo.w = 0u;
        const u32x2 ta = *(const LAS u32x2*)(Tm + (16 * b + fr) * LDT + 16 * b + 4 * fq);
        u32x4 ao; ao.x = ta.x; ao.y = ta.y; ao.z = 0u; ao.w = 0u;
        const f32x4 t10 = MFMA16(__builtin_bit_cast(bf16x8, ao), __builtin_bit_cast(bf16x8, bo), ((f32x4){0.f, 0.f, 0.f, 0.f}));
#pragma unroll
        for (int r = 0; r < 4; ++r) Tm[(16 * b + 4 * fq + r) * LDT + 16 * a + fr] = f2bf(-t10[r]);
    }
    asm volatile("s_waitcnt lgkmcnt(0)" ::: "memory");
    {
        bf16x8 xa2[2], tb2[2];
#pragma unroll
        for (int mt = 0; mt < 2; ++mt) { const f32x4 x0 = *(const LAS f32x4*)(X + (32 + 16 * mt + fr) * 64 + 8 * fq), x1 = *(const LAS f32x4*)(X + (32 + 16 * mt + fr) * 64 + 8 * fq + 4);
            u32x4 o; o.x = pk2(x0[0], x0[1]); o.y = pk2(x0[2], x0[3]); o.z = pk2(x1[0], x1[1]); o.w = pk2(x1[2], x1[3]); xa2[mt] = __builtin_bit_cast(bf16x8, o); }
#pragma unroll
        for (int nt = 0; nt < 2; ++nt) { unsigned tv[8];
#pragma unroll
            for (int e = 0; e < 8; ++e) tv[e] = Tm[(8 * fq + e) * LDT + 16 * nt + fr];
            u32x4 o; o.x = tv[0] | (tv[1] << 16); o.y = tv[2] | (tv[3] << 16); o.z = tv[4] | (tv[5] << 16); o.w = tv[6] | (tv[7] << 16); tb2[nt] = __builtin_bit_cast(bf16x8, o); }
        f32x4 m2[2][2];
#pragma unroll
        for (int mt = 0; mt < 2; ++mt)
#pragma unroll
            for (int nt = 0; nt < 2; ++nt) m2[mt][nt] = MFMA16(xa2[mt], tb2[nt], ((f32x4){0.f, 0.f, 0.f, 0.f}));
        bf16x8 bo[2], ao[2];
#pragma unroll
        for (int nt = 0; nt < 2; ++nt) { u32x4 o; o.x = pk2(m2[0][nt][0], m2[0][nt][1]); o.y = pk2(m2[0][nt][2], m2[0][nt][3]); o.z = pk2(m2[1][nt][0], m2[1][nt][1]); o.w = pk2(m2[1][nt][2], m2[1][nt][3]);
            bo[nt] = __builtin_bit_cast(bf16x8, o); }
#pragma unroll
        for (int mt = 0; mt < 2; ++mt) { const u32x2 lo = *(const LAS u32x2*)(Tm + (32 + 16 * mt + fr) * LDT + 32 + 4 * fq), hi = *(const LAS u32x2*)(Tm + (32 + 16 * mt + fr) * LDT + 48 + 4 * fq);
            u32x4 o; o.x = lo.x; o.y = lo.y; o.z = hi.x; o.w = hi.y; ao[mt] = __builtin_bit_cast(bf16x8, o); }
#pragma unroll
        for (int mt = 0; mt < 2; ++mt)
#pragma unroll
            for (int nt = 0; nt < 2; ++nt) { const f32x4 r2 = MFMA16(ao[mt], bo[nt], ((f32x4){0.f, 0.f, 0.f, 0.f}));
#pragma unroll
                for (int r = 0; r < 4; ++r) Tm[(32 + 16 * mt + 4 * fq + r) * LDT + 16 * nt + fr] = f2bf(-r2[r]); }
    }
    asm volatile("s_waitcnt lgkmcnt(0)" ::: "memory");
}

__device__ __forceinline__ int kperm(int c) { const int w = c & 31; return (c & 32) + 8 * ((w & 15) >> 2) + (w & 3) + 4 * (w >> 4); }

__device__ __forceinline__ void gdn_prep_unit(const Params& p, int l, int cid, int h, LAS unsigned char* lds) {
    lds = opaque_lds(lds);
    const int tid = opaque_tid(), lane = tid & 63, wv = __builtin_amdgcn_readfirstlane(tid >> 6), fr = lane & 15, fq = lane >> 4;
    const bf16_t* P1 = (const bf16_t*)(p.ws + WS_RB);
    const bf16_t* P2 = (const bf16_t*)((unsigned char*)p.out);
    bf16_t* OUT = (bf16_t*)(p.ws + WS_RD + (size_t)(cid * 6 + h) * GPREP_BYTES);
    float* AUX = (float*)(p.ws + WS_GAUX) + (size_t)(cid * 6 + h) * GAUX_N;
    LAS bf16_t* Qs = (LAS bf16_t*)lds;
    LAS bf16_t* Ks = Qs + 64 * LDT;
    LAS bf16_t* KT = Ks + 64 * LDT;
    LAS bf16_t* VT = KT + 64 * LDT;
    LAS bf16_t* Tf = VT + 64 * LDT;
    LAS bf16_t* Tb = Tf + 64 * LDT;
    LAS float* XB = (LAS float*)(Tb + 64 * LDT);
    LAS float* XA = (LAS float*)lds;
    LAS float* SER = XB + 4096;
    int set, p0, N;
    if (cid < 512) { set = cid >> 8; p0 = (cid & 255) * 64; N = T; } else { set = 2 + ((cid - 512) >> 2); p0 = ((cid - 512) & 3) * 64; N = TC; }
    if (wv < 3) {
        const int tg = lane >> 3, vsl = lane & 7, ch = wv * 384 + h * 64 + vsl * 8;
        const int ps = p0 + tg * 8;
        float wt[5][8];
#pragma unroll
        for (int k = 0; k < 5; ++k) { const float* w = p.gdn_conv_w + ((size_t)l * 5 + k) * 1152 + ch; const f32x4 a = *(const f32x4*)w, b = *(const f32x4*)(w + 4);
            wt[k][0] = a[0]; wt[k][1] = a[1]; wt[k][2] = a[2]; wt[k][3] = a[3]; wt[k][4] = b[0]; wt[k][5] = b[1]; wt[k][6] = b[2]; wt[k][7] = b[3]; }
        u32x4 win[12];
#pragma unroll
        for (int i = 0; i < 12; ++i) { const int pp = ps - 2 + i;
            win[i] = (pp >= 0 && pp < N) ? *(const u32x4*)(P2 + (size_t)gdn_pos_row(set, pp) * P2_LD + ch) : (u32x4){0u, 0u, 0u, 0u}; }
#pragma unroll
        for (int i = 0; i < 8; ++i) {
            float o[8];
#pragma unroll
            for (int e = 0; e < 8; ++e) o[e] = 0.f;
#pragma unroll
            for (int k = 0; k < 5; ++k) { float f[8]; unpack8(win[i + k], f);
#pragma unroll
                for (int e = 0; e < 8; ++e) o[e] += wt[k][e] * f[e]; }
            float ss = 0.f;
#pragma unroll
            for (int e = 0; e < 8; ++e) { o[e] = silu_f(o[e]); ss += o[e] * o[e]; }
            const int j = tg * 8 + i;
            if (wv < 2) {
                ss += __shfl_xor(ss, 1); ss += __shfl_xor(ss, 2); ss += __shfl_xor(ss, 4);
                const float sc = rsqrtf(ss + EPS) * (wv == 0 ? 0.125f : 1.f);
#pragma unroll
                for (int e = 0; e < 8; ++e) o[e] *= sc;
                u32x4 w; w.x = pk2(o[0], o[1]); w.y = pk2(o[2], o[3]); w.z = pk2(o[4], o[5]); w.w = pk2(o[6], o[7]);
                *(LAS u32x4*)((wv == 0 ? Qs : Ks) + j * LDT + vsl * 8) = w;
                if (wv == 1) {
#pragma unroll
                    for (int e = 0; e < 8; ++e) KT[(vsl * 8 + e) * LDT + j] = f2bf(o[e]); }
            } else {
#pragma unroll
                for (int e = 0; e < 8; ++e) VT[(vsl * 8 + e) * LDT + j] = f2bf(o[e]);
            }
        }
    } else {
        const size_t row = (size_t)gdn_pos_row(set, p0 + lane);
        float gc[2], beta[2];
#pragma unroll
        for (int dir = 0; dir < 2; ++dir) {
            const float ar = bf2f(P1[row * P1_LD + C_AR + dir * 6 + h]), br = bf2f(P1[row * P1_LD + C_BR + dir * 6 + h]);
            const float gg = -__expf(p.gdn_a_log[(l * 2 + dir) * 6 + h]) * softplus_f(ar + p.gdn_dt_bias[(l * 2 + dir) * 6 + h]);
            gc[dir] = wave_scan_dir(gg, lane, dir); beta[dir] = sigmoid_f(br);
        }
        const float gendf = __shfl(gc[0], 63), gendb = __shfl(gc[1], 0);
        SER[lane] = gc[0]; SER[64 + lane] = gc[1]; SER[128 + lane] = beta[0]; SER[192 + lane] = beta[1];
        SER[256 + lane] = -beta[0] * __expf(gc[0]); SER[320 + lane] = -beta[1] * __expf(gc[1]);
        AUX[lane] = __expf(gc[0]); AUX[64 + lane] = __expf(gc[1]); AUX[128 + lane] = __expf(gendf - gc[0]); AUX[192 + lane] = __expf(gendb - gc[1]);
        if (lane == 0) { AUX[256] = __expf(gendf); AUX[257] = __expf(gendb); }
    }
    __syncthreads();
    for (int c = tid; c < 1024; c += NTHR) { const int r = c >> 4, cc = (c & 15) * 4;
        *(u32x2*)(OUT + 5 * 4096 + r * 64 + kperm(cc)) = *(const LAS u32x2*)(Qs + r * LDT + cc);
        *(u32x2*)(OUT + 6 * 4096 + r * 64 + kperm(cc)) = *(const LAS u32x2*)(KT + r * LDT + cc); }
    {
        f32x4 kk[4], qk[4];
#pragma unroll
        for (int nt = 0; nt < 4; ++nt) { kk[nt] = (f32x4){0.f, 0.f, 0.f, 0.f}; qk[nt] = (f32x4){0.f, 0.f, 0.f, 0.f}; }
#pragma unroll
        for (int ks = 0; ks < 2; ++ks) {
            const bf16x8 kb = ldfrag(Ks, LDT, wv * 16, ks * 32, lane), qb = ldfrag(Qs, LDT, wv * 16, ks * 32, lane);
#pragma unroll
            for (int nt = 0; nt < 4; ++nt) { const bf16x8 ka = ldfrag(Ks, LDT, nt * 16, ks * 32, lane); kk[nt] = MFMA16(ka, kb, kk[nt]); qk[nt] = MFMA16(ka, qb, qk[nt]); }
        }
        __syncthreads();
        const int i = wv * 16 + fr;
        const float gcf_i = SER[i], gcb_i = SER[64 + i], bf_i = SER[128 + i], bb_i = SER[192 + i];
#pragma unroll
        for (int nt = 0; nt < 4; ++nt) {
            f32x4 xo; float at[4];
#pragma unroll
            for (int r = 0; r < 4; ++r) { const int j = nt * 16 + 4 * fq + r;
                float dec; xo[r] = 0.f;
                if (j < i) { dec = __expf(gcf_i - SER[j]); xo[r] = bf_i * kk[nt][r] * dec; }
                else if (j > i) { dec = __expf(gcb_i - SER[64 + j]); XB[(63 - i) * 64 + (63 - j)] = bb_i * kk[nt][r] * dec; }
                else dec = 1.f;
                at[r] = qk[nt][r] * dec; }
            *(LAS f32x4*)(XA + i * 64 + nt * 16 + 4 * fq) = xo;
            u32x2 w; w.x = pk2(at[0], at[1]); w.y = pk2(at[2], at[3]);
            *(u32x2*)(OUT + 4 * 4096 + i * 64 + kperm(nt * 16 + 4 * fq)) = w;
        }
    }
    __syncthreads();
    if (wv == 0) tri_solve_blk(XA, Tf, lane);
    else if (wv == 1) tri_solve_blk(XB, Tb, lane);
    __syncthreads();
    {
        const int dir = wv & 1, which = wv >> 1;
        const LAS bf16_t* Tm = dir ? Tb : Tf;
        const LAS bf16_t* Src = which ? KT : VT;
        const LAS float* scl = SER + (which ? 256 : 128) + dir * 64;
        bf16x8 tfr[4][2];
#pragma unroll
        for (int lt = 0; lt < 4; ++lt)
#pragma unroll
            for (int ks = 0; ks < 2; ++ks) tfr[lt][ks] = ldfrag(Tm, LDT, lt * 16, ks * 32, lane);
        bf16_t* dst = OUT + (which ? 0 : 2 * 4096) + dir * 4096;
#pragma unroll
        for (int vt = 0; vt < 4; ++vt) {
            bf16x8 sfr[2];
#pragma unroll
            for (int ks = 0; ks < 2; ++ks) {
                const int j0 = dir ? (56 - ks * 32 - fq * 8) : (ks * 32 + fq * 8);
                const u32x4 raw = *(const LAS u32x4*)(Src + (vt * 16 + fr) * LDT + j0);
                float f[8]; unpack8(raw, f);
                const LAS float* sp = scl + j0;
#pragma unroll
                for (int e = 0; e < 8; ++e) f[e] *= sp[e];
                u32x4 o;
                if (dir) { o.x = pk2(f[7], f[6]); o.y = pk2(f[5], f[4]); o.z = pk2(f[3], f[2]); o.w = pk2(f[1], f[0]); }
                else { o.x = pk2(f[0], f[1]); o.y = pk2(f[2], f[3]); o.z = pk2(f[4], f[5]); o.w = pk2(f[6], f[7]); }
                sfr[ks] = __builtin_bit_cast(bf16x8, o);
            }
#pragma unroll
            for (int lt = 0; lt < 4; ++lt) {
                f32x4 acc = (f32x4){0.f, 0.f, 0.f, 0.f};
#pragma unroll
                for (int ks = 0; ks < 2; ++ks) acc = which ? MFMA16(sfr[ks], tfr[lt][ks], acc) : MFMA16(tfr[lt][ks], sfr[ks], acc);
                if (which) { u32x2 w; w.x = pk2(acc[0], acc[1]); w.y = pk2(acc[2], acc[3]);
                    const int lrow = dir ? 63 - (lt * 16 + fr) : lt * 16 + fr;
                    *(u32x2*)(dst + lrow * 64 + kperm(vt * 16 + 4 * fq)) = w; }
                else if (dir) { u32x2 w; w.x = pk2(acc[3], acc[2]); w.y = pk2(acc[1], acc[0]);
                    *(u32x2*)(dst + (vt * 16 + fr) * 64 + 60 - (lt * 16 + 4 * fq)) = w; }
                else { u32x2 w; w.x = pk2(acc[0], acc[1]); w.y = pk2(acc[2], acc[3]);
                    *(u32x2*)(dst + (vt * 16 + fr) * 64 + lt * 16 + 4 * fq) = w; }
            }
        }
    }
    __syncthreads();
}

constexpr int SP_GDN_UNITS = NCHUNK * 6, SP_SSD_UNITS = NCHUNK * 2;
__device__ __forceinline__ void phase_gdn_prep(const Params& p, int l, LAS unsigned char* lds) {
    for (int it = 0; it < PADDED_ITERS(SP_GDN_UNITS); ++it) { int u = VB + it * NVB; if (u >= SP_GDN_UNITS) u = SP_GDN_UNITS - 1; gdn_prep_unit(p, l, u / 6, u % 6, lds); }
}

__device__ __forceinline__ int chain_cid(int b, int dir, int q) {
    if (q < 4) return 512 + b * 4 + (dir ? 3 - q : q);
    const int c = q - 4; return b * 256 + (dir ? 255 - c : c);
}
__device__ __forceinline__ unsigned mask_pair(unsigned w, bool keep_lo, bool keep_hi) { return (keep_lo ? (w & 0xffffu) : 0u) | (keep_hi ? (w & 0xffff0000u) : 0u); }

__device__ __forceinline__ unsigned pk2s(float lo, float hi) { return pk2(lo, hi); }
__device__ __forceinline__ void chain_compute(f32x4 (&S)[4], const LAS bf16_t* NWs, const LAS bf16_t* ATs, const LAS bf16_t* Qs, const LAS bf16_t* KTs, const LAS float* AX,
                                              const LAS bf16_t* Us, bf16_t* O, int cid, int h, int dir, bool last, int lane, int wv, int fr, int fq, const u32x4 (&amask)[2]) {
    const int sw = fr >> 1;
#define CH_FRAG(T, mt, ks) (*(const LAS bf16x8*)((T) + ((mt) * 16 + fr) * 64 + (((4 * (ks) + fq) ^ sw) * 8)))
    bf16x8 nwf[4][2], qf[4][2]; float eg[4]; u32x2 uw[4];
#pragma unroll
    for (int mt = 0; mt < 4; ++mt) uw[mt] = *(const LAS u32x2*)(Us + (wv * 16 + fr) * 64 + (((2 * mt + (fq >> 1)) ^ sw) * 8) + (fq & 1) * 4);
#pragma unroll
    for (int mt = 0; mt < 4; ++mt) {
        nwf[mt][0] = CH_FRAG(NWs, mt, 0); nwf[mt][1] = CH_FRAG(NWs, mt, 1);
        qf[mt][0] = CH_FRAG(Qs, mt, 0); qf[mt][1] = CH_FRAG(Qs, mt, 1);
        eg[mt] = AX[mt * 16 + fr];
    }
    const float gend = AX[128];
    u32x4 sp0, sp1;
    sp0.x = pk2(S[0][0], S[0][1]); sp0.y = pk2(S[0][2], S[0][3]); sp0.z = pk2(S[1][0], S[1][1]); sp0.w = pk2(S[1][2], S[1][3]);
    sp1.x = pk2(S[2][0], S[2][1]); sp1.y = pk2(S[2][2], S[2][3]); sp1.z = pk2(S[3][0], S[3][1]); sp1.w = pk2(S[3][2], S[3][3]);
    const bf16x8 sb0 = __builtin_bit_cast(bf16x8, sp0), sb1 = __builtin_bit_cast(bf16x8, sp1);
    f32x4 vn[4], oo[4];
#pragma unroll
    for (int mt = 0; mt < 4; ++mt) {
        f32x4 a = (f32x4){__uint_as_float(uw[mt].x << 16), __uint_as_float(uw[mt].x & 0xffff0000u), __uint_as_float(uw[mt].y << 16), __uint_as_float(uw[mt].y & 0xffff0000u)};
        a = MFMA16(nwf[mt][0], sb0, a);
        a = MFMA16(nwf[mt][1], sb1, a);
        vn[mt] = a;
    }
    bf16x8 ktf[4][2]; u32x4 atw[4][2]; f32x4 ep[4];
#pragma unroll
    for (int mt = 0; mt < 4; ++mt) {
        ktf[mt][0] = CH_FRAG(KTs, mt, 0); ktf[mt][1] = CH_FRAG(KTs, mt, 1);
        atw[mt][0] = __builtin_bit_cast(u32x4, CH_FRAG(ATs, mt, 0)); atw[mt][1] = __builtin_bit_cast(u32x4, CH_FRAG(ATs, mt, 1));
        ep[mt] = *(const LAS f32x4*)(AX + 64 + mt * 16 + 4 * fq);
    }
#pragma unroll
    for (int mt = 0; mt < 4; ++mt) {
        f32x4 o = (f32x4){0.f, 0.f, 0.f, 0.f};
        o = MFMA16(sb0, qf[mt][0], o);
        o = MFMA16(sb1, qf[mt][1], o);
        f32x2 eg2 = (f32x2){eg[mt], eg[mt]}; asm volatile("" : "+v"(eg2));
        const f32x2 o01 = (f32x2){o[0], o[1]} * eg2, o23 = (f32x2){o[2], o[3]} * eg2;
        oo[mt] = (f32x4){o01[0], o01[1], o23[0], o23[1]};
    }
    u32x4 vp0, vp1, vq0, vq1;
    vp0.x = pk2(vn[0][0], vn[0][1]); vp0.y = pk2(vn[0][2], vn[0][3]); vp0.z = pk2(vn[1][0], vn[1][1]); vp0.w = pk2(vn[1][2], vn[1][3]);
    vp1.x = pk2(vn[2][0], vn[2][1]); vp1.y = pk2(vn[2][2], vn[2][3]); vp1.z = pk2(vn[3][0], vn[3][1]); vp1.w = pk2(vn[3][2], vn[3][3]);
    vq0.x = pk2(vn[0][0] * ep[0][0], vn[0][1] * ep[0][1]); vq0.y = pk2(vn[0][2] * ep[0][2], vn[0][3] * ep[0][3]); vq0.z = pk2(vn[1][0] * ep[1][0], vn[1][1] * ep[1][1]); vq0.w = pk2(vn[1][2] * ep[1][2], vn[1][3] * ep[1][3]);
    vq1.x = pk2(vn[2][0] * ep[2][0], vn[2][1] * ep[2][1]); vq1.y = pk2(vn[2][2] * ep[2][2], vn[2][3] * ep[2][3]); vq1.z = pk2(vn[3][0] * ep[3][0], vn[3][1] * ep[3][1]); vq1.w = pk2(vn[3][2] * ep[3][2], vn[3][3] * ep[3][3]);
    const bf16x8 vb0 = __builtin_bit_cast(bf16x8, vp0), vb1 = __builtin_bit_cast(bf16x8, vp1), vc0 = __builtin_bit_cast(bf16x8, vq0), vc1 = __builtin_bit_cast(bf16x8, vq1);
    f32x2 gend2 = (f32x2){gend, gend}; asm volatile("" : "+v"(gend2));
#pragma unroll
    for (int mt = 0; mt < 4; ++mt) {
        f32x4 sn;
#pragma unroll
        for (int r = 0; r < 4; r += 2) { const f32x2 t2 = (f32x2){S[mt][r], S[mt][r + 1]} * gend2; sn[r] = t2[0]; sn[r + 1] = t2[1]; }
        sn = MFMA16(ktf[mt][0], vc0, sn);
        sn = MFMA16(ktf[mt][1], vc1, sn);
        S[mt] = sn;
    }
#pragma unroll
    for (int mt = 0; mt < 4; ++mt) {
        const int kd = mt >> 1;
        u32x4 aw = atw[mt][kd];
        aw.x &= amask[mt & 1].x; aw.y &= amask[mt & 1].y; aw.z &= amask[mt & 1].z; aw.w &= amask[mt & 1].w;
        oo[mt] = MFMA16(kd ? vb1 : vb0, __builtin_bit_cast(bf16x8, aw), oo[mt]);
        const bool other = dir ? (mt < 2) : (mt >= 2);
        if (other) oo[mt] = MFMA16(kd ? vb0 : vb1, __builtin_bit_cast(bf16x8, atw[mt][kd ^ 1]), oo[mt]);
    }
    if (!(last && cid >= 512)) {
        bf16_t* ob = O + (size_t)(cid * 6 + h) * 4096 + fr * 64 + wv * 16 + 4 * fq;
#pragma unroll
        for (int mt = 0; mt < 4; ++mt) { u32x2 w; w.x = pk2(oo[mt][0], oo[mt][1]); w.y = pk2(oo[mt][2], oo[mt][3]); *(u32x2*)(ob + mt * 1024) = w; }
    }
}
#undef CH_FRAG

__device__ __forceinline__ void gdn_chain(const Params& p, int l, int chain, LAS unsigned char* lds, bool loader) {
    lds = opaque_lds(lds);
    const int tid = opaque_tid(), lane = tid & 63, wv = __builtin_amdgcn_readfirstlane(tid >> 6), fr = lane & 15, fq = lane >> 4;
    const int b = chain / 12, h = (chain % 12) >> 1, dir = chain & 1;
    const bool last = (l == NL - 1);
    bf16_t* O = (bf16_t*)((unsigned char*)p.out) + (size_t)dir * NCHUNK * 6 * 4096;
    constexpr int TSET = 5 * 4096;
    LAS bf16_t* TB = (LAS bf16_t*)lds;
    LAS float* AXB = (LAS float*)(TB + 3 * TSET);
    f32x4 S[4];
#pragma unroll
    for (int mt = 0; mt < 4; ++mt) S[mt] = (f32x4){0.f, 0.f, 0.f, 0.f};
    u32x4 amask[2];
#pragma unroll
    for (int par = 0; par < 2; ++par) { unsigned w[4];
#pragma unroll
        for (int j = 0; j < 4; ++j) { bool k[2];
#pragma unroll
            for (int x = 0; x < 2; ++x) { const int e = 2 * j + x; const int lp = (e < 4) ? (4 * fq + e) : (16 + 4 * fq + e - 4);
                const int dd = 16 * par + fr - lp;
                k[x] = dir ? (dd <= 0) : (dd >= 0); }
            w[j] = (k[0] ? 0xffffu : 0u) | (k[1] ? 0xffff0000u : 0u); }
        amask[par] = (u32x4){w[0], w[1], w[2], w[3]}; }
    if (loader) {
        const int i = tid & 63;
        unsigned soff[2], doff[2];
#pragma unroll
        for (int j = 0; j < 2; ++j) { const int pc = 2 * wv + j, r = pc * 8 + (i >> 3), pch = i & 7;
            soff[j] = (unsigned)(r * 128 + ((pch ^ ((r >> 1) & 7)) * 16)); doff[j] = (unsigned)(pc * 1024 + i * 16); }
        const int auxi = tid < 64 ? dir * 64 + tid : (tid < 128 ? 128 + dir * 64 + (tid - 64) : 256 + dir);
#define CH_DMA(q, set) do { \
        const int cid_ = chain_cid(b, dir, (q)); \
        const char* sb_ = (const char*)(p.ws + WS_RD + (size_t)(cid_ * 6 + h) * GPREP_BYTES); \
        LAS unsigned char* db_ = (LAS unsigned char*)(TB + (set) * TSET); \
        _Pragma("unroll") for (int t5 = 0; t5 < 5; ++t5) { const int gk = t5 == 0 ? dir : (t5 == 4 ? 2 + dir : 3 + t5);        \
            _Pragma("unroll") for (int j = 0; j < 2; ++j) __builtin_amdgcn_global_load_lds((const unsigned*)(sb_ + gk * 8192 + soff[j]), (LAS unsigned*)(db_ + t5 * 8192 + doff[j]), 16, 0, 0); } \
        const float* aux_ = (const float*)(p.ws + WS_GAUX) + (size_t)(cid_ * 6 + h) * GAUX_N; \
        __builtin_amdgcn_global_load_lds((const unsigned*)(aux_ + auxi), (LAS unsigned*)(AXB + (set) * 256 + tid), 4, 0, 0); \
    } while (0)
        CH_DMA(0, 0); CH_DMA(1, 1);
        asm volatile("s_waitcnt vmcnt(11)" ::: "memory");
        int ws = 2;
        for (int q = 0; q < 260; ++q) {
            __builtin_amdgcn_s_barrier(); asm volatile("" ::: "memory");
            if (q + 2 < 260) { CH_DMA(q + 2, ws); asm volatile("s_waitcnt vmcnt(11)" ::: "memory"); }
            else asm volatile("s_waitcnt vmcnt(0)" ::: "memory");
            ws = (ws == 2) ? 0 : ws + 1;
        }
#undef CH_DMA
    } else {
        int rs = 0;
        for (int q = 0; q < 260; ++q) {
            const int cid = chain_cid(b, dir, q);
            asm volatile("s_waitcnt lgkmcnt(0)" ::: "memory"); __builtin_amdgcn_s_barrier(); asm volatile("" ::: "memory");
            const LAS bf16_t* tb_ = TB + rs * TSET;
            chain_compute(S, tb_, tb_ + 4096, tb_ + 2 * 4096, tb_ + 3 * 4096, AXB + rs * 256, tb_ + 4 * 4096, O, cid, h, dir, last, lane, wv, fr, fq, amask);
            rs = (rs == 2) ? 0 : rs + 1;
        }
    }
    asm volatile("s_waitcnt vmcnt(0) lgkmcnt(0)" ::: "memory"); __builtin_amdgcn_s_barrier(); asm volatile("" ::: "memory");
}

__device__ __forceinline__ void ssd_scan_unit(const Params& p, int u) {
    const int tid = LTID;
    const int part = u & 15, hh = (u >> 4) % 6, bb = ((u >> 4) / 6) & 1, dir = (u >> 4) / 12;
    unsigned* SS = (unsigned*)(p.ws + WS_RA);
    float* SSDCD = (float*)(p.ws + WS_SSDCD);
    const size_t eoff = (size_t)part * 256 + tid;
    float s0 = 0.f, s1 = 0.f;
    for (int q0 = 0; q0 < 260; q0 += 4) {
        unsigned v[4]; float cd[4]; size_t idx[4];
#pragma unroll
        for (int i = 0; i < 4; ++i) { const int cid = chain_cid(bb, dir, q0 + i);
            idx[i] = (((size_t)dir * NCHUNK + cid) * 6 + hh) * 4096 + eoff; v[i] = SS[idx[i]]; cd[i] = __hip_atomic_load(SSDCD + ((size_t)dir * NCHUNK + cid) * 6 + hh, __ATOMIC_RELAXED, __HIP_MEMORY_SCOPE_AGENT); }
#pragma unroll
        for (int i = 0; i < 4; ++i) {
            const float l0 = __uint_as_float(v[i] << 16), l1 = __uint_as_float(v[i] & 0xffff0000u);
            SS[idx[i]] = pk2(s0, s1);
            s0 = s0 * cd[i] + l0; s1 = s1 * cd[i] + l1;
        }
    }
}

constexpr int LDW = 136;
__device__ __forceinline__ void ssd_passC_unit(const Params& p, int l, int cid, int h, LAS unsigned char* lds) {
    lds = opaque_lds(lds);
    const int tid = opaque_tid(), lane = tid & 63, wv = __builtin_amdgcn_readfirstlane(tid >> 6), fr = lane & 15, fq = lane >> 4;
    const int g = h / 3;
    const bf16_t* P1 = (const bf16_t*)(p.ws + WS_RB);
    const bf16_t* SS = (const bf16_t*)(p.ws + WS_RA);
    bf16_t* YS = (bf16_t*)((unsigned char*)p.out) + (size_t)2 * NROWS * 384;
    float* SSQP = (float*)(p.ws + WS_SSQP);
    LAS bf16_t* XT = (LAS bf16_t*)lds;
    LAS bf16_t* Bs = XT + 64 * LDT;
    LAS bf16_t* Cs = Bs + 64 * LDW;
    LAS bf16_t* As = Cs + 64 * LDW;
    LAS float* SER = (LAS float*)(As + 64 * LDT);
    int t0, N; ssd_chunk_geom(cid, t0, N);
    const int row0 = cid * 64;
    bf16x8 stf[4], stb[4];
    { const bf16_t* STf = SS + (((size_t)0 * NCHUNK + cid) * 6 + h) * 8192 + (size_t)(wv * 16 + fr) * 128 + fq * 8;
      const bf16_t* STb = SS + (((size_t)1 * NCHUNK + cid) * 6 + h) * 8192 + (size_t)(wv * 16 + fr) * 128 + fq * 8;
#pragma unroll
      for (int ks = 0; ks < 4; ++ks) { stf[ks] = *(const bf16x8*)(STf + ks * 32); stb[ks] = *(const bf16x8*)(STb + ks * 32); } }
    if (wv < 2) {
        const int dir = wv;
        const float dtr = bf2f(P1[(size_t)(row0 + lane) * P1_LD + C_DT + dir * 6 + h]);
        const float dt = softplus_f(dtr + p.ssd_dt_bias[(l * 2 + dir) * 6 + h]);
        const float a = -__expf(p.ssd_a_log[(l * 2 + dir) * 6 + h]);
        SER[dir * 128 + lane] = dt; SER[dir * 128 + 64 + lane] = wave_scan_dir(dt * a, lane, dir);
    }
    for (int pass = 0; pass < 2; ++pass) {
        const int vs = pass * 32 + (tid & 31), tg = tid >> 5;
        if (vs < 40) {
            const int kind = vs < 8 ? 0 : (vs < 24 ? 1 : 2);
            const int ch = kind == 0 ? (h * 64 + vs * 8) : (kind == 1 ? (384 + g * 128 + (vs - 8) * 8) : (640 + g * 128 + (vs - 24) * 8));
            conv8_slide(P1 + C_XS + ch, P1_LD, row0 + tg * 8, 1, t0 + tg * 8, N, p.ssd_conv_w + (size_t)l * 5 * 896 + ch, 896, p.ssd_conv_b + l * 896 + ch,
                [&](int i, const float (&o)[8]) {
                    const int j = tg * 8 + i;
                    if (kind == 0) {
#pragma unroll
                        for (int e = 0; e < 8; ++e) XT[(vs * 8 + e) * LDT + j] = f2bf(o[e]); }
                    else { u32x4 w; w.x = pk2(o[0], o[1]); w.y = pk2(o[2], o[3]); w.z = pk2(o[4], o[5]); w.w = pk2(o[6], o[7]);
                        *(LAS u32x4*)((kind == 1 ? Bs : Cs) + j * LDW + (kind == 1 ? vs - 8 : vs - 24) * 8) = w; }
                });
        }
    }
    __syncthreads();
    {
        f32x4 G[4];
#pragma unroll
        for (int jt = 0; jt < 4; ++jt) G[jt] = (f32x4){0.f, 0.f, 0.f, 0.f};
#pragma unroll
        for (int ks = 0; ks < 4; ++ks) { const bf16x8 cf = ldfrag(Cs, LDW, wv * 16, ks * 32, lane);
#pragma unroll
            for (int jt = 0; jt < 4; ++jt) G[jt] = MFMA16(ldfrag(Bs, LDW, jt * 16, ks * 32, lane), cf, G[jt]); }
        const int irow = wv * 16 + fr;
        const LAS float* dtf = SER; const LAS float* acf = SER + 64; const LAS float* dtb = SER + 128; const LAS float* acb = SER + 192;
        const float acf_i = acf[irow], acb_i = acb[irow];
#pragma unroll
        for (int jt = 0; jt < 4; ++jt) {
            float a[4];
#pragma unroll
            for (int r = 0; r < 4; ++r) { const int j = jt * 16 + 4 * fq + r; float c = 0.f;
                if (j <= irow) c += __expf(acf_i - acf[j]) * dtf[j];
                if (j >= irow) c += __expf(acb_i - acb[j]) * dtb[j];
                a[r] = G[jt][r] * c; }
            u32x2 w; w.x = pk2(a[0], a[1]); w.y = pk2(a[2], a[3]);
            *(LAS u32x2*)(As + irow * LDT + jt * 16 + 4 * fq) = w;
        }
    }
    __syncthreads();
    {
        const bf16x8 xf0 = ldfrag(XT, LDT, wv * 16, 0, lane), xf1 = ldfrag(XT, LDT, wv * 16, 32, lane);
        const float dsk = p.ssd_d[l * 6 + h];
#pragma unroll
        for (int it = 0; it < 4; ++it) {
            f32x4 y = (f32x4){0.f, 0.f, 0.f, 0.f}, yf = y, yb = y;
            y = MFMA16(xf0, ldfrag(As, LDT, it * 16, 0, lane), y);
            y = MFMA16(xf1, ldfrag(As, LDT, it * 16, 32, lane), y);
#pragma unroll
            for (int ks = 0; ks < 4; ++ks) { const bf16x8 cf = ldfrag(Cs, LDW, it * 16, ks * 32, lane); yf = MFMA16(stf[ks], cf, yf); yb = MFMA16(stb[ks], cf, yb); }
            const int i = it * 16 + fr;
            const size_t grow = (size_t)(row0 + i);
            const float eaf = __expf(SER[64 + i]), eab = __expf(SER[192 + i]);
            const u32x2 zw = *(const u32x2*)(P1 + grow * P1_LD + C_Z + h * 64 + wv * 16 + 4 * fq);
            const float z[4] = {__uint_as_float(zw.x << 16), __uint_as_float(zw.x & 0xffff0000u), __uint_as_float(zw.y << 16), __uint_as_float(zw.y & 0xffff0000u)};
            float o[4], ssq = 0.f;
#pragma unroll
            for (int r = 0; r < 4; ++r) { const float xv = bf2f(XT[(wv * 16 + 4 * fq + r) * LDT + i]);
                o[r] = (y[r] + eaf * yf[r] + eab * yb[r] + dsk * xv) * silu_f(z[r]);
                const float ob = bf2f(f2bf(o[r])); ssq += ob * ob; }
            u32x2 w; w.x = pk2(o[0], o[1]); w.y = pk2(o[2], o[3]);
            *(u32x2*)(YS + grow * 384 + h * 64 + wv * 16 + 4 * fq) = w;
            ssq += __shfl_xor(ssq, 16); ssq += __shfl_xor(ssq, 32);
            if (fq == 0) SSQP[grow * 24 + h * 4 + wv] = ssq;
        }
    }
    __syncthreads();
}

constexpr int N_CHAIN_WG = 24;
__device__ __forceinline__ void phase_chain(const Params& p, int l, LAS unsigned char* lds, LAS unsigned char* ldsh, const XcdBarrier& side) {
    if (blockIdx.x < N_CHAIN_WG) {
        const int reps =
#if defined(REPEAT_CHAIN)
            2;
#else
            1;
#endif
        for (int rp = 0; rp < reps; ++rp) {
            gdn_chain(p, l, blockIdx.x, lds, (VB & 1) != 0);
        }
        return; }
    phase_inproj<1>(p, l, lds, blockIdx.x - N_CHAIN_WG, gridDim.x - N_CHAIN_WG);
    { const int nbc = NVB - 2 * N_CHAIN_WG, mec = VB - 2 * N_CHAIN_WG;
      for (int it = 0; it < (SIDE_CONV_UNITS + nbc - 1) / nbc; ++it) { int v = mec + it * nbc; if (v >= SIDE_CONV_UNITS) v = SIDE_CONV_UNITS - 1; conv_weight_tile(p, l, 4096 + v, ldsh, LTID); } }
    xcd_barrier(side);
    const int nb = NVB - 2 * N_CHAIN_WG, me = VB - 2 * N_CHAIN_WG;
    const int it_a = (SP_SSD_UNITS + nb - 1) / nb;
    for (int it = 0; it < it_a; ++it) { int u = me + it * nb; if (u >= SP_SSD_UNITS) u = SP_SSD_UNITS - 1; ssd_passA_unit(p, l, u >> 1, u & 1, ldsh); }
    xcd_barrier(side);
    for (int u = me; u < 384; u += nb) ssd_scan_unit(p, u);
    xcd_barrier(side);
    const int nu = ((l == NL - 1) ? 512 : NCHUNK) * 6;
    const int it_c = (nu + nb - 1) / nb;
    for (int it = 0; it < it_c; ++it) { int u = me + it * nb; if (u >= nu) u = nu - 1; ssd_passC_unit(p, l, u / 6, u % 6, ldsh); }
}

__device__ __forceinline__ const float* ldp(const LAS unsigned* s, int i) {
    const unsigned lo = __builtin_amdgcn_readfirstlane(s[2 * i]), hi = __builtin_amdgcn_readfirstlane(s[2 * i + 1]);
    return (const float*)(((unsigned long long)hi << 32) | (unsigned long long)lo);
}
__device__ __forceinline__ Params load_params(const LAS unsigned* s) {
    Params q;
    q.x = ldp(s, 0); q.c = ldp(s, 1); q.ctx = ldp(s, 2); q.c_ctx = ldp(s, 3); q.norm1_g = ldp(s, 4); q.norm2_g = ldp(s, 5); q.ada_w = ldp(s, 6); q.ada_b = ldp(s, 7);
    q.w_in = ldp(s, 8); q.w_out = ldp(s, 9); q.pool_w = ldp(s, 10); q.pool_scale = ldp(s, 11); q.ssd_conv_w = ldp(s, 12); q.ssd_conv_b = ldp(s, 13); q.ssd_a_log = ldp(s, 14);
    q.ssd_dt_bias = ldp(s, 15); q.ssd_d = ldp(s, 16); q.ssd_norm_g = ldp(s, 17); q.gdn_conv_w = ldp(s, 18); q.gdn_a_log = ldp(s, 19); q.gdn_dt_bias = ldp(s, 20); q.gdn_norm_g = ldp(s, 21);
    q.router_w = ldp(s, 22); q.exp_w_gate = ldp(s, 23); q.exp_w_up = ldp(s, 24); q.exp_w_down = ldp(s, 25); q.final_norm_g = ldp(s, 26);
    q.out = (float*)ldp(s, 27); q.ws = (unsigned char*)ldp(s, 28); q.ph_lo = 0; q.ph_hi = 0;
    return q;
}

constexpr int PH_PER_LAYER = 10;
constexpr int N_PHASES = 2 + PH_PER_LAYER * NL;

__global__ void __launch_bounds__(WG_THREADS, 2) mega(const Params pk) {
    extern __shared__ __attribute__((aligned(16))) unsigned char smem[];
    LAS unsigned char* lds = (LAS unsigned char*)smem;
    LAS unsigned char* ldsh = lds + __builtin_amdgcn_readfirstlane((int)(threadIdx.x >> 8)) * LDS_HALF;
    volatile LAS unsigned* xbw = (volatile LAS unsigned*)(lds + LDS_BYTES);
    if (threadIdx.x < 4) xbw[threadIdx.x] = 0u;
    __syncthreads();
    const int lo = __builtin_amdgcn_readfirstlane(pk.ph_lo), hi = __builtin_amdgcn_readfirstlane(pk.ph_hi);
    const bool multi = (hi - lo) > 1;
    unsigned* barw = (unsigned*)(pk.ws + WS_CTL);
    XcdBarrier bar; bar.bar = barw; bar.x = 0; bar.st = xbw; bar.G = gridDim.x;
    if (multi) bar = xcd_barrier_post(barw, xbw, gridDim.x);
    XcdBarrier side; side.bar = (unsigned*)(pk.ws + WS_CTL2); side.x = 0; side.st = xbw + 2; side.G = gridDim.x - N_CHAIN_WG;
    if (blockIdx.x >= N_CHAIN_WG) side = xcd_barrier_post((unsigned*)(pk.ws + WS_CTL2), xbw + 2, gridDim.x - N_CHAIN_WG);
#ifndef REPEAT_MASK
#define REPEAT_MASK 0u
#endif
#define PH_KIND(ph) ((ph) == 0 ? 12 : ((ph) == 1 ? 13 : (((ph) - 2) % PH_PER_LAYER)))
#define RUN_PH(ph, call) if (lo <= (ph) && (ph) < hi) { { const Params& p = pk; call; if ((REPEAT_MASK >> PH_KIND(ph)) & 1u) { __syncthreads(); call; } } if ((ph) + 1 < hi) xcd_barrier(bar); }
    RUN_PH(0, phase0(p, ldsh))
    RUN_PH(1, phase_norm1(p))
#define RUN_LAYER(l) \
    RUN_PH(2 + PH_PER_LAYER * (l) + 0, (phase_inproj<0>(p, (l), lds, blockIdx.x, gridDim.x))) \
    RUN_PH(2 + PH_PER_LAYER * (l) + 1, phase_gdn_prep(p, (l), ldsh)) \
    RUN_PH(2 + PH_PER_LAYER * (l) + 2, phase_chain(p, (l), lds, ldsh, side)) \
    RUN_PH(2 + PH_PER_LAYER * (l) + 3, phase_post_tok(p, (l))) \
    RUN_PH(2 + PH_PER_LAYER * (l) + 4, phase_outproj(p, (l), lds)) \
    RUN_PH(2 + PH_PER_LAYER * (l) + 5, phase_norm2_router(p, (l), ldsh)) \
    RUN_PH(2 + PH_PER_LAYER * (l) + 6, phase_topk_conv(p, (l), ldsh)) \
    RUN_PH(2 + PH_PER_LAYER * (l) + 7, phase_exp1(p, (l), lds)) \
    RUN_PH(2 + PH_PER_LAYER * (l) + 8, phase_exp2(p, (l), lds)) \
    RUN_PH(2 + PH_PER_LAYER * (l) + 9, phase_combine(p, (l)))
    RUN_LAYER(0)
    RUN_LAYER(1)
}

#ifndef N_LAUNCH_MODE
#define N_LAUNCH_MODE 1
#endif
extern "C" void kernel_launch(void* const* d_in, const int* in_sizes, int n_in, void* d_out, int out_size, void* d_ws, size_t ws_size, hipStream_t stream) {
    static int grid = 0;
    const size_t lds_total = LDS_BYTES + 16;
    if (grid == 0) {
        if (n_in != 27 || ws_size < WS_END) { fprintf(stderr, "kernel_launch: unexpected n_in %d or ws_size %zu (need %zu)\n", n_in, ws_size, (size_t)WS_END); grid = -1; return; }
        int dev = 0, cus = 0, per_cu = 0;
        (void)hipGetDevice(&dev); (void)hipDeviceGetAttribute(&cus, hipDeviceAttributeMultiprocessorCount, dev);
        (void)hipFuncSetAttribute((const void*)mega, hipFuncAttributeMaxDynamicSharedMemorySize, (int)lds_total);
        (void)hipOccupancyMaxActiveBlocksPerMultiprocessor(&per_cu, (const void*)mega, WG_THREADS, lds_total);
        if (per_cu < 1) { fprintf(stderr, "kernel_launch: occupancy query returned %d\n", per_cu); grid = -1; return; }
        if (per_cu > 1) per_cu = 1;
        grid = cus * per_cu;
        fprintf(stderr, "kernel_launch: cus %d per_cu %d grid %d ws %zu need %zu\n", cus, per_cu, grid, ws_size, (size_t)WS_END);
    }
    if (grid < 0) return;
    Params p{};
    const float** pp = (const float**)&p;
    for (int i = 0; i < 27; ++i) pp[i] = (const float*)d_in[i];
    p.out = (float*)d_out; p.ws = (unsigned char*)d_ws;
    (void)hipMemsetAsync((char*)d_ws + WS_CTL, 0, 32768, stream);
#if N_LAUNCH_MODE == 1
    p.ph_lo = 0; p.ph_hi = N_PHASES;
    void* args[] = {&p};
    hipError_t e = hipLaunchCooperativeKernel((const void*)mega, dim3(grid), dim3(WG_THREADS), args, lds_total, stream);
    if (e != hipSuccess) fprintf(stderr, "cooperative launch failed: %s (grid %d)\n", hipGetErrorString(e), grid);
#else
    for (int ph = 0; ph < N_PHASES; ++ph) {
        p.ph_lo = ph; p.ph_hi = ph + 1;
        hipLaunchKernelGGL(mega, dim3(grid), dim3(WG_THREADS), lds_total, stream, p);
    }
#endif
}
```
